# Optimizing an MI355X kernel written in HIP

```python
import math
import jax
import jax.numpy as jnp
from jax import lax
import numpy as np

D_MODEL = 2048
BATCH = 2
SEQ = 16384
DEPTH = 2

GRID_W = 64
CTX_LEN = 256
D_FF = 4 * D_MODEL
NORM_EPS = 1e-6

D_A = D_MODEL // 2
HY_EMB = 33
HY_FW = 64
HY_SHORT = 3
HY_DECAY_PCT_HI = 0.3
HY_DECAY_PCT_LO = 1.5
HY_TARGET = 1e-2

D_B = D_MODEL - D_A
RW_HEAD = 64
H_B = D_B // RW_HEAD
LORA_W = 96
LORA_A = 96
LORA_G = 256
RW_LN_EPS = 64e-5

D_C = D_MODEL // 2
H_C = 8
DV_C = D_C // H_C
E_C = 128
K_C = H_C * E_C
CHUNK = 64

D_D = D_MODEL - D_C
H_D = 16
BLK_D = D_D // H_D
CONV_D = 4
RG_C = 8.0

N_EVEN = (DEPTH + 1) // 2
N_ODD = DEPTH // 2

HY_COLS = 3 * D_A
RW_SPLITS = [D_B, 2 * D_B, 3 * D_B, 3 * D_B + 2 * LORA_W, 3 * D_B + 2 * LORA_W + 2 * LORA_A]
RW_COLS = 3 * D_B + 2 * LORA_W + 2 * LORA_A + LORA_G
EVEN_IN = HY_COLS + RW_COLS
HG_SPLITS = [K_C, 3 * K_C, 3 * K_C + D_C]
HG_COLS = 3 * K_C + 2 * D_C
ODD_IN = HG_COLS + 2 * D_D

kernel_name = 'hybrid_hyena_rwkv7_hgrn2_rglru_dit'


def rms_norm(x, w):
    xf = x.astype(jnp.float32)
    y = xf * lax.rsqrt(jnp.mean(xf * xf, -1, keepdims=True) + NORM_EPS)
    return (y * w.astype(jnp.float32)).astype(x.dtype)


def modulate(h, shift, scale):
    return h * (1 + scale) + shift


def sq_relu_mlp(h, w1, w2):
    return jnp.square(jax.nn.relu(h @ w1)) @ w2


def _flip(t):
    return jnp.flip(t, axis=1)


def depthwise_conv(x, w, b, left, right):
    L = x.shape[1]
    xp = jnp.pad(x, ((0, 0), (left, right), (0, 0)))
    y = b
    for k in range(w.shape[0]):
        y = y + xp[:, k:k + L] * w[k]
    return y


def centred_token_shift(p, mu):
    pp = jnp.pad(p, ((0, 0), (1, 1), (0, 0)))
    return p + (0.5 * (pp[:, :-2] + pp[:, 2:]) - p) * mu


def to_col_major(h):
    B, T, D = h.shape
    rows = T // GRID_W
    return h.reshape(B, rows, GRID_W, D).transpose(0, 2, 1, 3).reshape(B, T, D)


def from_col_major(h):
    B, T, D = h.shape
    rows = T // GRID_W
    return h.reshape(B, GRID_W, rows, D).transpose(0, 2, 1, 3).reshape(B, T, D)


def hyena_filters(L, w1, b1, w2, b2, w3, freq):
    f32 = jnp.float32
    t = jnp.linspace(0.0, 1.0, L, dtype=f32)[:, None]
    bands = (HY_EMB - 1) // 2
    w = 2.0 * math.pi * jnp.arange(L, dtype=f32)[:, None] / L
    fr = jnp.linspace(1e-4, bands - 1, bands, dtype=f32)[None, :]
    z = jnp.concatenate([t, jnp.cos(fr * w), -jnp.sin(fr * w)], axis=-1)
    freq = freq.astype(f32)
    h = jnp.sin(freq[0] * (z @ w1.astype(f32) + b1.astype(f32)))
    h = jnp.sin(freq[1] * (h @ w2.astype(f32) + b2.astype(f32)))
    h = (h @ w3.astype(f32)).reshape(L, 2, 2, D_A)
    deltas = jnp.abs(jnp.linspace(math.log(HY_TARGET) / HY_DECAY_PCT_LO,
                                  math.log(HY_TARGET) / HY_DECAY_PCT_HI, D_A, dtype=f32))
    h = h * jnp.exp(-t[:, :, None, None] * deltas)
    causal = h[:, :, 0]
    anti = h[1:, :, 1][::-1]
    taps = jnp.concatenate([causal, jnp.zeros((1, 2, D_A), f32), anti], axis=0)
    taps = taps / jnp.sum(jnp.abs(taps), axis=0, keepdims=True)
    return jnp.fft.rfft(taps, axis=0)


def long_conv(u, kf, bias):
    L = u.shape[1]
    uf = jnp.fft.rfft(u, n=2 * L, axis=1)
    y = jnp.fft.irfft(uf * kf, n=2 * L, axis=1)[:, :L]
    return y + u * bias


def hyena_mix(p, conv_w, conv_b, f_w1, f_b1, f_w2, f_b2, f_w3, freq, bias):
    L = p.shape[1]
    p = depthwise_conv(p, conv_w, conv_b, 1, 1).astype(jnp.float32)
    v, x1, x2 = jnp.split(p, 3, axis=-1)
    kf = hyena_filters(L, f_w1, f_b1, f_w2, f_b2, f_w3, freq)
    bias = bias.astype(jnp.float32)
    z = x1 * long_conv(v, kf[:, 0], bias[0])
    return x2 * long_conv(z, kf[:, 1], bias[1])


def wkv7_scan(r, w, k, v, kk, a, s0):
    def step(S, inp):
        r_t, w_t, k_t, v_t, kk_t, a_t = inp
        sa = jnp.einsum('bhvk,bhk->bhv', S, kk_t)
        S = (S * w_t[:, :, None, :] - sa[..., None] * (kk_t * a_t)[:, :, None, :]
             + v_t[..., None] * k_t[:, :, None, :])
        return S, jnp.einsum('bhvk,bhk->bhv', S, r_t)
    xs = tuple(jnp.moveaxis(t, 1, 0) for t in (r, w, k, v, kk, a))
    s, y = lax.scan(step, s0, xs)
    return jnp.moveaxis(y, 0, 1), s


def rwkv7_mix(pl, pc, mu, w0, w2, a0, a2, g2, k_k, k_a, r_k, ln_w, ln_b, ctx_out):
    f32 = jnp.float32

    def feats(p):
        B, L, _ = p.shape
        p = centred_token_shift(p, mu).astype(f32)
        r, k, v, wd, ad, gd = jnp.split(p, RW_SPLITS, axis=-1)
        wd = wd.reshape(B, L, 2, LORA_W)
        ad = ad.reshape(B, L, 2, LORA_A)
        w_log = -jax.nn.softplus(-(w0 + jnp.einsum('bldr,drc->bldc', jnp.tanh(wd), w2))) - 0.5
        decay = jnp.exp(-jnp.exp(w_log))
        a = jax.nn.sigmoid(a0 + jnp.einsum('bldr,drc->bldc', ad, a2))
        g = jax.nn.sigmoid(gd) @ g2
        kk = (k * k_k).reshape(B, L, H_B, RW_HEAD)
        kk = kk * lax.rsqrt(jnp.maximum(jnp.sum(kk * kk, -1, keepdims=True), 1e-24))
        kd = k[:, :, None] * (1 + (a - 1) * k_a)
        heads2 = lambda t: t.reshape(B, L, 2, H_B, RW_HEAD)
        return (r.reshape(B, L, H_B, RW_HEAD), heads2(decay), heads2(kd),
                v.reshape(B, L, H_B, RW_HEAD), kk, heads2(a), g)

    def run(ft, s0f, s0b):
        r, dec, kd, v, kk, a, _ = ft
        yf, sf = wkv7_scan(r, dec[:, :, 0], kd[:, :, 0], v, kk, a[:, :, 0], s0f)
        yb, sb = wkv7_scan(_flip(r), _flip(dec[:, :, 1]), _flip(kd[:, :, 1]), _flip(v), _flip(kk),
                           _flip(a[:, :, 1]), s0b)
        return yf + _flip(yb), sf, sb

    def readout(ft, y):
        r, _, kd, v, _, _, g = ft
        B, L = y.shape[:2]
        m = jnp.mean(y, -1, keepdims=True)
        var = jnp.mean(jnp.square(y - m), -1, keepdims=True)
        o = ((y - m) * lax.rsqrt(var + RW_LN_EPS)).reshape(B, L, D_B) * ln_w + ln_b
        bonus = jnp.sum(r[:, :, None] * kd * r_k, axis=(2, 4))[..., None] * v
        return (o + bonus.reshape(B, L, D_B)) * g

    fc = feats(pc)
    zero = jnp.zeros((pc.shape[0], H_B, RW_HEAD, RW_HEAD), f32)
    yc, sf, sb = run(fc, zero, zero)
    fl = feats(pl)
    yl, _, _ = run(fl, sf, sb)
    return readout(fl, yl), (readout(fc, yc) if ctx_out else None)


def hgrn2_chunk_scan(q, logf, k, v, s0):
    B, L, H, E = q.shape
    n = L // CHUNK
    blocks = lambda t: t.reshape(B, n, CHUNK, H, t.shape[-1]).transpose(1, 0, 3, 2, 4)
    mask = jnp.tril(jnp.ones((CHUNK, CHUNK), bool))[:, :, None]

    def step(S, inp):
        qc, gc, kc, vc = inp
        b = jnp.cumsum(gc, axis=2)
        o = jnp.einsum('bhte,bhev->bhtv', qc * jnp.exp(b), S)
        diff = b[:, :, :, None, :] - b[:, :, None, :, :]
        dec = jnp.exp(jnp.where(mask, diff, -jnp.inf))
        att = jnp.einsum('bhte,bhtse,bhse->bhts', qc, dec, kc)
        o = o + jnp.einsum('bhts,bhsv->bhtv', att, vc)
        b_end = b[:, :, -1]
        S = (jnp.exp(b_end)[..., None] * S
             + jnp.einsum('bhse,bhsv->bhev', kc * jnp.exp(b_end[:, :, None] - b), vc))
        return S, o

    s, o = lax.scan(step, s0, (blocks(q), blocks(logf), blocks(k), blocks(v)))
    return o.transpose(1, 0, 3, 2, 4).reshape(B, L, H, -1), s


def hgrn2_mix(pl, pc, lb, gn_w, ctx_out):
    f32 = jnp.float32
    lb = lb.reshape(2, H_C, E_C)

    def feats(p):
        B, L, _ = p.shape
        q, fz, i, g = jnp.split(p.astype(f32), HG_SPLITS, axis=-1)
        f = lb + (1.0 - lb) * jax.nn.sigmoid(fz.reshape(B, L, 2, H_C, E_C))
        return (jax.nn.silu(q).reshape(B, L, H_C, E_C), jnp.log(f), 1.0 - f,
                i.reshape(B, L, H_C, DV_C), jax.nn.silu(g))

    def run(ft, s0f, s0b):
        q, logf, k, i, _ = ft
        of, sf = hgrn2_chunk_scan(q, logf[:, :, 0], k[:, :, 0], i, s0f)
        ob, sb = hgrn2_chunk_scan(_flip(q), _flip(logf[:, :, 1]), _flip(k[:, :, 1]), _flip(i), s0b)
        return of + _flip(ob), sf, sb

    def readout(ft, o):
        B, L = o.shape[:2]
        o = o * lax.rsqrt(jnp.mean(o * o, -1, keepdims=True) + NORM_EPS)
        return o.reshape(B, L, D_C) * gn_w * ft[4]

    fc = feats(pc)
    zero = jnp.zeros((pc.shape[0], H_C, E_C, DV_C), f32)
    oc, sf, sb = run(fc, zero, zero)
    fl = feats(pl)
    ol, _, _ = run(fl, sf, sb)
    return readout(fl, ol), (readout(fc, oc) if ctx_out else None)


def linear_scan(a, u, h0):
    comb = lambda l, r: (l[0] * r[0], r[0] * l[1] + r[1])
    A, Hs = lax.associative_scan(comb, (a, u), axis=1)
    h = Hs + A * h0[:, None]
    return h, h[:, -1]


def rglru_mix(pl, pc, conv_w, conv_b, wa, ba, wx, bx, lam, ctx_out):
    f32 = jnp.float32
    lam = lam.reshape(2, H_D, BLK_D)

    def feats(p):
        B, L, _ = p.shape
        xb, gb = jnp.split(p, 2, axis=-1)
        xb = depthwise_conv(xb, conv_w, conv_b, 2, 1).astype(f32).reshape(B, L, H_D, BLK_D)
        ra = jax.nn.sigmoid(jnp.einsum('blhi,dhij->bldhj', xb, wa) + ba)
        ix = jax.nn.sigmoid(jnp.einsum('blhi,dhij->bldhj', xb, wx) + bx)
        log_a = -RG_C * ra * jax.nn.softplus(-lam)
        u = jnp.sqrt(-jnp.expm1(2.0 * log_a)) * ix * xb[:, :, None]
        return (jnp.exp(log_a).reshape(B, L, 2, D_D), u.reshape(B, L, 2, D_D),
                jax.nn.gelu(gb.astype(f32), approximate=True))

    def run(ft, h0f, h0b):
        a, u, _ = ft
        hf, lf = linear_scan(a[:, :, 0], u[:, :, 0], h0f)
        hb, lbk = linear_scan(_flip(a[:, :, 1]), _flip(u[:, :, 1]), h0b)
        return hf + _flip(hb), lf, lbk

    fc = feats(pc)
    zero = jnp.zeros((pc.shape[0], D_D), f32)
    hc, hf, hb = run(fc, zero, zero)
    fl = feats(pl)
    hl, _, _ = run(fl, hf, hb)
    return hl * fl[2], (hc * fc[2] if ctx_out else None)


def even_mixer(hl, hc, w_in, w_out, hy_conv_w, hy_conv_b, hy_f_w1, hy_f_b1, hy_f_w2, hy_f_b2, hy_f_w3,
               hy_freq, hy_bias, rw_mu, rw_w0, rw_w2, rw_a0, rw_a2, rw_g2, rw_k_k, rw_k_a, rw_r_k,
               rw_ln_w, rw_ln_b, ctx_out):
    dt = hl.dtype
    pl = hl @ w_in
    pc = hc @ (w_in if ctx_out else w_in[:, HY_COLS:])
    pc_rw = pc[..., HY_COLS:] if ctx_out else pc
    hy_args = (hy_conv_w, hy_conv_b, hy_f_w1, hy_f_b1, hy_f_w2, hy_f_b2, hy_f_w3, hy_freq, hy_bias)
    y_hy_l = hyena_mix(pl[..., :HY_COLS], *hy_args)
    y_rw_l, y_rw_c = rwkv7_mix(pl[..., HY_COLS:], pc_rw, rw_mu, rw_w0, rw_w2, rw_a0, rw_a2, rw_g2,
                               rw_k_k, rw_k_a, rw_r_k, rw_ln_w, rw_ln_b, ctx_out)
    ol = jnp.concatenate([y_hy_l, y_rw_l], axis=-1).astype(dt) @ w_out
    oc = None
    if ctx_out:
        y_hy_c = hyena_mix(pc[..., :HY_COLS], *hy_args)
        oc = jnp.concatenate([y_hy_c, y_rw_c], axis=-1).astype(dt) @ w_out
    return ol, oc


def odd_mixer(hl, hc, w_in, w_out, lb, hg_norm_w, rg_conv_w, rg_conv_b, rg_wa, rg_ba, rg_wx, rg_bx,
              rg_lam, ctx_out):
    dt = hl.dtype
    pl = to_col_major(hl) @ w_in
    pc = hc @ w_in
    y_hg_l, y_hg_c = hgrn2_mix(pl[..., :HG_COLS], pc[..., :HG_COLS], lb, hg_norm_w, ctx_out)
    y_rg_l, y_rg_c = rglru_mix(pl[..., HG_COLS:], pc[..., HG_COLS:], rg_conv_w, rg_conv_b, rg_wa, rg_ba,
                               rg_wx, rg_bx, rg_lam, ctx_out)
    ol = from_col_major(jnp.concatenate([y_hg_l, y_rg_l], axis=-1).astype(dt) @ w_out)
    oc = (jnp.concatenate([y_hg_c, y_rg_c], axis=-1).astype(dt) @ w_out) if ctx_out else None
    return ol, oc


def setup_inputs(seed: int = 0) -> dict:
    key = jax.random.key(seed)
    ks = iter(jax.random.split(key, 64))
    f32 = jnp.float32
    nrm = lambda shape, s=1.0: s * jax.random.normal(next(ks), shape, f32)
    lin = jnp.linspace(0.0, 1.0, D_B, dtype=f32)
    decay_speed = -6.0 + 5.0 * lin ** 0.9
    u = jax.random.uniform(next(ks), (N_ODD, 2, D_D), f32, 0.9, 0.999)
    a_base = u ** (1.0 / RG_C)
    rg_lam = jnp.log(a_base) - jnp.log1p(-a_base)
    D = D_MODEL
    return {
        'x': nrm((BATCH, SEQ, D)),
        'c': nrm((BATCH, D)),
        'ctx': nrm((BATCH, CTX_LEN, D)),
        'c_ctx': nrm((D,)),
        'ada_w': nrm((DEPTH, D, 6 * D), 0.5 * D ** -0.5),
        'ada_b': nrm((DEPTH, 6 * D), 0.02),
        'norm_w': 1.0 + nrm((DEPTH, 2, D), 0.02),
        'mlp_w1': nrm((DEPTH, D, D_FF), D ** -0.5),
        'mlp_w2': nrm((DEPTH, D_FF, D), D_FF ** -0.5),
        'final_norm_w': 1.0 + nrm((D,), 0.02),
        'ev_w_in': nrm((N_EVEN, D, EVEN_IN), D ** -0.5),
        'ev_w_out': nrm((N_EVEN, D_A + D_B, D), (D_A + D_B) ** -0.5),
        'hy_conv_w': nrm((N_EVEN, HY_SHORT, HY_COLS), HY_SHORT ** -0.5),
        'hy_conv_b': nrm((N_EVEN, HY_COLS), 0.02),
        'hy_f_w1': nrm((N_EVEN, HY_EMB, HY_FW), HY_EMB ** -0.5),
        'hy_f_b1': nrm((N_EVEN, HY_FW), 0.02),
        'hy_f_w2': nrm((N_EVEN, HY_FW, HY_FW), HY_FW ** -0.5),
        'hy_f_b2': nrm((N_EVEN, HY_FW), 0.02),
        'hy_f_w3': nrm((N_EVEN, HY_FW, 4 * D_A), HY_FW ** -0.5),
        'hy_freq': 1.0 + nrm((N_EVEN, 2, HY_FW), 0.1),
        'hy_bias': nrm((N_EVEN, 2, D_A), 0.5),
        'rw_mu': jax.random.uniform(next(ks), (N_EVEN, RW_COLS), f32),
        'rw_w0': decay_speed + 0.5 + nrm((N_EVEN, 2, D_B), 0.1),
        'rw_w2': nrm((N_EVEN, 2, LORA_W, D_B), 0.5 * LORA_W ** -0.5),
        'rw_a0': nrm((N_EVEN, 2, D_B), 0.1),
        'rw_a2': nrm((N_EVEN, 2, LORA_A, D_B), 0.5 * LORA_A ** -0.5),
        'rw_g2': nrm((N_EVEN, LORA_G, D_B), LORA_G ** -0.5),
        'rw_k_k': 0.85 + nrm((N_EVEN, D_B), 0.05),
        'rw_k_a': 1.0 + nrm((N_EVEN, D_B), 0.05),
        'rw_r_k': nrm((N_EVEN, H_B, RW_HEAD), 0.1),
        'rw_ln_w': 1.0 + nrm((N_EVEN, D_B), 0.02),
        'rw_ln_b': nrm((N_EVEN, D_B), 0.02),
        'od_w_in': nrm((N_ODD, D, ODD_IN), D ** -0.5),
        'od_w_out': nrm((N_ODD, D_C + D_D, D), (D_C + D_D) ** -0.5),
        'hg_lb': nrm((DEPTH, 2, K_C), 0.1),
        'hg_norm_w': 1.0 + nrm((N_ODD, D_C), 0.02),
        'rg_conv_w': nrm((N_ODD, CONV_D, D_D), CONV_D ** -0.5),
        'rg_conv_b': nrm((N_ODD, D_D), 0.02),
        'rg_wa': nrm((N_ODD, 2, H_D, BLK_D, BLK_D), BLK_D ** -0.5),
        'rg_ba': nrm((N_ODD, 2, H_D, BLK_D), 0.02),
        'rg_wx': nrm((N_ODD, 2, H_D, BLK_D, BLK_D), BLK_D ** -0.5),
        'rg_bx': nrm((N_ODD, 2, H_D, BLK_D), 0.02),
        'rg_lam': rg_lam,
    }


def reference(x, c, ctx, c_ctx, ada_w, ada_b, norm_w, mlp_w1, mlp_w2, final_norm_w,
              ev_w_in, ev_w_out, hy_conv_w, hy_conv_b, hy_f_w1, hy_f_b1, hy_f_w2, hy_f_b2, hy_f_w3,
              hy_freq, hy_bias, rw_mu, rw_w0, rw_w2, rw_a0, rw_a2, rw_g2, rw_k_k, rw_k_a, rw_r_k,
              rw_ln_w, rw_ln_b, od_w_in, od_w_out, hg_lb, hg_norm_w, rg_conv_w, rg_conv_b, rg_wa,
              rg_ba, rg_wx, rg_bx, rg_lam):
    lb_p = jax.nn.softmax(hg_lb.astype(jnp.float32), axis=0)
    lb_all = jnp.cumsum(lb_p, axis=0) - lb_p[0]
    s_lat = jax.nn.silu(c)
    s_ctx = jax.nn.silu(c_ctx)
    xl, xc = x, ctx
    for l in range(DEPTH):
        last = l == DEPTH - 1
        ml = jnp.split((s_lat @ ada_w[l] + ada_b[l])[:, None, :], 6, axis=-1)
        mc = jnp.split(s_ctx @ ada_w[l] + ada_b[l], 6, axis=-1)
        hl = modulate(rms_norm(xl, norm_w[l, 0]), ml[0], ml[1])
        hc = modulate(rms_norm(xc, norm_w[l, 0]), mc[0], mc[1])
        j = l // 2
        if l % 2 == 0:
            ol, oc = even_mixer(hl, hc, ev_w_in[j], ev_w_out[j], hy_conv_w[j], hy_conv_b[j], hy_f_w1[j],
                                hy_f_b1[j], hy_f_w2[j], hy_f_b2[j], hy_f_w3[j], hy_freq[j], hy_bias[j],
                                rw_mu[j], rw_w0[j], rw_w2[j], rw_a0[j], rw_a2[j], rw_g2[j], rw_k_k[j],
                                rw_k_a[j], rw_r_k[j], rw_ln_w[j], rw_ln_b[j], not last)
        else:
            ol, oc = odd_mixer(hl, hc, od_w_in[j], od_w_out[j], lb_all[l], hg_norm_w[j], rg_conv_w[j],
                               rg_conv_b[j], rg_wa[j], rg_ba[j], rg_wx[j], rg_bx[j], rg_lam[j], not last)
        xl = xl + ml[2] * ol
        xl = xl + ml[5] * sq_relu_mlp(modulate(rms_norm(xl, norm_w[l, 1]), ml[3], ml[4]), mlp_w1[l], mlp_w2[l])
        if not last:
            xc = xc + mc[2] * oc
            xc = xc + mc[5] * sq_relu_mlp(modulate(rms_norm(xc, norm_w[l, 1]), mc[3], mc[4]),
                                          mlp_w1[l], mlp_w2[l])
    return rms_norm(xl, final_norm_w)
```

```cpp
#include <hip/hip_runtime.h>
#include <hip/hip_cooperative_groups.h>
#include <cstdio>
namespace cg = cooperative_groups;

typedef unsigned short bf16_t;
typedef short bf16x8 __attribute__((ext_vector_type(8)));
typedef float f32x4 __attribute__((ext_vector_type(4)));

#define NT 512
#define MLAT 32768
#define MALL 33280
#define LSEQ 16384
#define MiB (1048576ull)

struct Params {
  const float *x, *c, *ctx, *c_ctx, *ada_w, *ada_b, *norm_w, *mlp_w1, *mlp_w2, *final_norm_w;
  const float *ev_w_in, *ev_w_out, *hy_conv_w, *hy_conv_b, *hy_f_w1, *hy_f_b1, *hy_f_w2, *hy_f_b2, *hy_f_w3, *hy_freq, *hy_bias;
  const float *rw_mu, *rw_w0, *rw_w2, *rw_a0, *rw_a2, *rw_g2, *rw_k_k, *rw_k_a, *rw_r_k, *rw_ln_w, *rw_ln_b;
  const float *od_w_in, *od_w_out, *hg_lb, *hg_norm_w, *rg_conv_w, *rg_conv_b, *rg_wa, *rg_ba, *rg_wx, *rg_bx, *rg_lam;
  float* out;
  float* mod; float2* tw; float2* half; bf16_t* h2b; bf16_t* h2cb; float* tapsc; float* xc; float* bonus; bf16_t* w3t; bf16_t* g2t;
  bf16_t *w_in_t, *w_out_t, *w1_t, *w2_t;
  bf16_t* H;
  bf16_t* RP;
  bf16_t* RA;
};

__device__ __forceinline__ float bf2f(bf16_t v) { return __uint_as_float(((unsigned)v) << 16); }
__device__ __forceinline__ bf16_t f2bf(float f) { unsigned u = __float_as_uint(f); u += 0x7fffu + ((u >> 16) & 1u); return (bf16_t)(u >> 16); }
__device__ __forceinline__ unsigned pack2(float a, float b) { return (unsigned)f2bf(a) | ((unsigned)f2bf(b) << 16); }
__device__ __forceinline__ float sigmoidf_(float x) { return 1.f / (1.f + expf(-x)); }
__device__ __forceinline__ float siluf_(float x) { return x / (1.f + expf(-x)); }
__device__ __forceinline__ float gelu_tanh_(float x) { return 0.5f * x * (1.f + tanhf(0.7978845608f * (x + 0.044715f * x * x * x))); }
__device__ __forceinline__ float2 cmul(float2 a, float2 b) { return make_float2(a.x * b.x - a.y * b.y, a.x * b.y + a.y * b.x); }
__device__ __forceinline__ float2 cmulc(float2 a, float2 b) { return make_float2(a.x * b.x + a.y * b.y, a.y * b.x - a.x * b.y); }
__device__ __forceinline__ void unpack8(bf16x8 v, float* o) {
#pragma unroll
  for (int j = 0; j < 8; ++j) o[j] = bf2f((bf16_t)v[j]);
}
__device__ __forceinline__ void row_info(int row, int& pos, int& len) {
  if (row < MLAT) { pos = row & (LSEQ - 1); len = LSEQ; } else { pos = (row - MLAT) & 255; len = 256; }
}
__device__ __forceinline__ int step_row(int s, int b, int dir, int& pos, int& len) {
  if (s < 256) { len = 256; pos = dir ? 255 - s : s; return MLAT + b * 256 + pos; }
  len = LSEQ; int ls = s - 256; pos = dir ? LSEQ - 1 - ls : ls; return b * LSEQ + pos;
}
__device__ __forceinline__ float wave_sum(float v) {
#pragma unroll
  for (int m = 32; m >= 1; m >>= 1) v += __shfl_xor(v, m);
  return v;
}
__device__ __forceinline__ float block_sum(float v, float* red) {
  v = wave_sum(v);
  __syncthreads();
  if ((threadIdx.x & 63) == 0) red[threadIdx.x >> 6] = v;
  __syncthreads();
  float s = 0.f;
#pragma unroll
  for (int i = 0; i < 8; ++i) s += red[i];
  __syncthreads();
  return s;
}

__device__ __forceinline__ void rw_shift8(const bf16_t* __restrict__ prw, const float* __restrict__ mu, int row, int pos, int len, int c, float* o) {
  const bf16_t* p = prw + (size_t)row * 3712 + c;
  bf16x8 cur = *(const bf16x8*)p;
  bf16x8 z = {0, 0, 0, 0, 0, 0, 0, 0};
  bf16x8 prv = pos > 0 ? *(const bf16x8*)(p - 3712) : z;
  bf16x8 nxt = pos < len - 1 ? *(const bf16x8*)(p + 3712) : z;
  float4 m0 = *(const float4*)(mu + c), m1 = *(const float4*)(mu + c + 4);
  float mm[8] = {m0.x, m0.y, m0.z, m0.w, m1.x, m1.y, m1.z, m1.w};
#pragma unroll
  for (int j = 0; j < 8; ++j) {
    float cc = bf2f((bf16_t)cur[j]), pp = bf2f((bf16_t)prv[j]), nn = bf2f((bf16_t)nxt[j]);
    o[j] = cc + (0.5f * (pp + nn) - cc) * mm[j];
  }
}

struct ALoadPlain {
  const bf16_t* A; size_t lda;
  __device__ __forceinline__ bf16x8 operator()(int row, int k) const { return *(const bf16x8*)(A + (size_t)row * lda + k); }
};
struct ALoadG {
  const bf16_t* prw; const float* mu;
  __device__ __forceinline__ bf16x8 operator()(int row, int k) const {
    int pos, len; row_info(row, pos, len);
    float v[8]; rw_shift8(prw, mu, row, pos, len, 3456 + k, v);
    bf16x8 r;
#pragma unroll
    for (int j = 0; j < 8; ++j) r[j] = (short)f2bf(sigmoidf_(v[j]));
    return r;
  }
};

template <bool TRANS, class AL, class EP>
__device__ __forceinline__ void gemm_tile(const AL& al, const bf16_t* __restrict__ Bt, int K, int row0, int col0, const EP& ep, char* smem) {
  constexpr int LDT = 72;
  bf16_t* sA0 = (bf16_t*)smem;
  bf16_t* sB0 = sA0 + 256 * LDT;
  bf16_t* sA1 = (bf16_t*)(smem + 55296);
  bf16_t* sB1 = sA1 + 256 * LDT;
  const int tid = threadIdx.x, wave = tid >> 6, lane = tid & 63, wm = wave >> 1, wn = wave & 1, fr = lane & 15, fq = lane >> 4;
  const int lr = tid >> 3, lk = (tid & 7) * 8;
  f32x4 acc[4][4];
#pragma unroll
  for (int i = 0; i < 4; ++i)
#pragma unroll
    for (int j = 0; j < 4; ++j) acc[i][j] = (f32x4){0.f, 0.f, 0.f, 0.f};
  bf16x8 ra[4], rb[2];
  const int nk = K >> 6;
#pragma unroll
  for (int i = 0; i < 4; ++i) ra[i] = al(row0 + lr + 64 * i, lk);
#pragma unroll
  for (int i = 0; i < 2; ++i) rb[i] = *(const bf16x8*)(Bt + (size_t)(col0 + lr + 64 * i) * K + lk);
#pragma unroll
  for (int i = 0; i < 4; ++i) *(bf16x8*)(sA0 + (lr + 64 * i) * LDT + lk) = ra[i];
#pragma unroll
  for (int i = 0; i < 2; ++i) *(bf16x8*)(sB0 + (lr + 64 * i) * LDT + lk) = rb[i];
  __syncthreads();
  for (int kt = 0; kt < nk; ++kt) {
    const bool more = kt + 1 < nk;
    if (more) {
      const int k0 = (kt + 1) * 64 + lk;
#pragma unroll
      for (int i = 0; i < 4; ++i) ra[i] = al(row0 + lr + 64 * i, k0);
#pragma unroll
      for (int i = 0; i < 2; ++i) rb[i] = *(const bf16x8*)(Bt + (size_t)(col0 + lr + 64 * i) * K + k0);
    }
    const bf16_t* cA = (kt & 1) ? sA1 : sA0;
    const bf16_t* cB = (kt & 1) ? sB1 : sB0;
#pragma unroll
    for (int ks = 0; ks < 2; ++ks) {
      bf16x8 af[4], bfr[4];
#pragma unroll
      for (int mi = 0; mi < 4; ++mi) af[mi] = *(const bf16x8*)(cA + (wm * 64 + mi * 16 + fr) * LDT + ks * 32 + fq * 8);
#pragma unroll
      for (int ni = 0; ni < 4; ++ni) bfr[ni] = *(const bf16x8*)(cB + (wn * 64 + ni * 16 + fr) * LDT + ks * 32 + fq * 8);
#pragma unroll
      for (int mi = 0; mi < 4; ++mi)
#pragma unroll
        for (int ni = 0; ni < 4; ++ni) {
          if (TRANS) acc[mi][ni] = __builtin_amdgcn_mfma_f32_16x16x32_bf16(af[mi], bfr[ni], acc[mi][ni], 0, 0, 0);
          else acc[mi][ni] = __builtin_amdgcn_mfma_f32_16x16x32_bf16(bfr[ni], af[mi], acc[mi][ni], 0, 0, 0);
        }
    }
    if (more) {
      bf16_t* nA = (kt & 1) ? sA0 : sA1;
      bf16_t* nB = (kt & 1) ? sB0 : sB1;
#pragma unroll
      for (int i = 0; i < 4; ++i) *(bf16x8*)(nA + (lr + 64 * i) * LDT + lk) = ra[i];
#pragma unroll
      for (int i = 0; i < 2; ++i) *(bf16x8*)(nB + (lr + 64 * i) * LDT + lk) = rb[i];
    }
    __syncthreads();
  }
#pragma unroll
  for (int mi = 0; mi < 4; ++mi)
#pragma unroll
    for (int ni = 0; ni < 4; ++ni) {
      if (TRANS) ep(row0 + wm * 64 + mi * 16 + fq * 4, col0 + wn * 64 + ni * 16 + fr, acc[mi][ni]);
      else ep(row0 + wm * 64 + mi * 16 + fr, col0 + wn * 64 + ni * 16 + fq * 4, acc[mi][ni]);
    }
}

template <bool TRANS, class AL, class EP>
__device__ __forceinline__ int gemm_run(const AL& al, const bf16_t* Bt, int K, int M, int N, const EP& ep, char* smem, int gbase) {
  const int nM = M >> 8, nN = N >> 7, nt = nM * nN, G = gridDim.x;
  const int g0 = gbase + ((((int)blockIdx.x - gbase) % G) + G) % G;
  const int nig = 8 * nN;
  for (int g = g0; g < gbase + nt; g += G) {
    const int tile = g - gbase;
    const int gid = tile / nig, fm = gid * 8, gsz = min(8, nM - fm);
    const int pm = fm + (tile % nig) % gsz, pn = (tile % nig) / gsz;
    gemm_tile<TRANS>(al, Bt, K, pm * 256, pn * 128, ep, smem);
  }
  return gbase + nt;
}

struct EpTransBf16 {
  bf16_t* dst; size_t ld;
  __device__ __forceinline__ void operator()(int row, int col, f32x4 v) const {
    uint2 u; u.x = pack2(v[0], v[1]); u.y = pack2(v[2], v[3]);
    *(uint2*)(dst + (size_t)col * ld + row) = u;
  }
};
struct EpTransF32 {
  float* dst; size_t ld;
  __device__ __forceinline__ void operator()(int row, int col, f32x4 v) const { *(f32x4*)(dst + (size_t)col * ld + row) = v; }
};
struct EpBf16 {
  bf16_t* dst; size_t ld;
  __device__ __forceinline__ void operator()(int row, int col, f32x4 v) const {
    uint2 u; u.x = pack2(v[0], v[1]); u.y = pack2(v[2], v[3]);
    *(uint2*)(dst + (size_t)row * ld + col) = u;
  }
};
struct EpSqRelu {
  bf16_t* dst; size_t ld;
  __device__ __forceinline__ void operator()(int row, int col, f32x4 v) const {
    float a = fmaxf(v[0], 0.f), b = fmaxf(v[1], 0.f), c = fmaxf(v[2], 0.f), d = fmaxf(v[3], 0.f);
    uint2 u; u.x = pack2(a * a, b * b); u.y = pack2(c * c, d * d);
    *(uint2*)(dst + (size_t)row * ld + col) = u;
  }
};
struct EpResid {
  const float* src_lat; const float* src_ctx; float* dst_lat; float* dst_ctx; const float* modl; int chunk; int unperm;
  __device__ __forceinline__ void operator()(int row, int col, f32x4 v) const {
    const float* s; float* d; int which;
    if (row < MLAT) {
      int r = row; which = row >> 14;
      if (unperm) { int tp = row & (LSEQ - 1); r = (row & ~(LSEQ - 1)) + (tp & 255) * 64 + (tp >> 8); }
      s = src_lat + (size_t)r * 2048 + col; d = dst_lat + (size_t)r * 2048 + col;
    } else { which = 2; s = src_ctx + (size_t)(row - MLAT) * 2048 + col; d = dst_ctx + (size_t)(row - MLAT) * 2048 + col; }
    f32x4 g = *(const f32x4*)(modl + which * 12288 + chunk * 2048 + col);
    f32x4 x = *(const f32x4*)s;
    *(f32x4*)d = x + g * v;
  }
};
struct EpIn1 {
  bf16_t* dst; const float* hg_lb;
  __device__ __forceinline__ void operator()(int row, int col, f32x4 v) const {
    float o[4];
    if (col < 1024 || (col >= 4096 && col < 5120)) {
#pragma unroll
      for (int j = 0; j < 4; ++j) o[j] = siluf_(v[j]);
    } else if (col < 3072) {
#pragma unroll
      for (int j = 0; j < 4; ++j) {
        int i = col - 1024 + j;
        float lb = 1.f / (1.f + expf(hg_lb[i] - hg_lb[2048 + i]));
        o[j] = (1.f - lb) / (1.f + expf(v[j]));
      }
    } else if (col >= 6144) {
#pragma unroll
      for (int j = 0; j < 4; ++j) o[j] = gelu_tanh_(v[j]);
    } else {
#pragma unroll
      for (int j = 0; j < 4; ++j) o[j] = v[j];
    }
    uint2 u; u.x = pack2(o[0], o[1]); u.y = pack2(o[2], o[3]);
    *(uint2*)(dst + (size_t)row * 7168 + col) = u;
  }
};

__device__ void adaln_task(const Params& P, char* smem, int task) {
  float* s = (float*)smem;
  float* red = s + 3 * 2048;
  const int tid = threadIdx.x, l = task / 96, cgp = task % 96;
  for (int i = tid; i < 3 * 2048; i += NT) {
    int w = i >> 11, k = i & 2047;
    float v = (w < 2) ? P.c[w * 2048 + k] : P.c_ctx[k];
    s[i] = siluf_(v);
  }
  __syncthreads();
  const int c4 = tid & 31, ks = tid >> 5;
  const float* W = P.ada_w + (size_t)l * 2048 * 12288 + cgp * 128 + c4 * 4;
  float a0[4] = {0, 0, 0, 0}, a1[4] = {0, 0, 0, 0}, a2[4] = {0, 0, 0, 0};
  for (int k = ks * 128; k < ks * 128 + 128; ++k) {
    float4 w = *(const float4*)(W + (size_t)k * 12288);
    float s0 = s[k], s1 = s[2048 + k], s2 = s[4096 + k];
    a0[0] += s0 * w.x; a0[1] += s0 * w.y; a0[2] += s0 * w.z; a0[3] += s0 * w.w;
    a1[0] += s1 * w.x; a1[1] += s1 * w.y; a1[2] += s1 * w.z; a1[3] += s1 * w.w;
    a2[0] += s2 * w.x; a2[1] += s2 * w.y; a2[2] += s2 * w.z; a2[3] += s2 * w.w;
  }
#pragma unroll
  for (int j = 0; j < 4; ++j) {
    red[(ks * 3 + 0) * 128 + c4 * 4 + j] = a0[j];
    red[(ks * 3 + 1) * 128 + c4 * 4 + j] = a1[j];
    red[(ks * 3 + 2) * 128 + c4 * 4 + j] = a2[j];
  }
  __syncthreads();
  if (tid < 384) {
    int w = tid >> 7, cc = tid & 127;
    float sum = 0.f;
    for (int k = 0; k < 16; ++k) sum += red[(k * 3 + w) * 128 + cc];
    int col = cgp * 128 + cc;
    P.mod[(size_t)(l * 3 + w) * 12288 + col] = sum + P.ada_b[l * 12288 + col];
  }
  __syncthreads();
}

__device__ void cvt_tile(const float* __restrict__ src, int K, int N, bf16_t* __restrict__ dst, int tile, char* smem) {
  float* t = (float*)smem;
  const int tid = threadIdx.x, nT = N >> 6, kt = tile / nT, nt = tile % nT;
#pragma unroll
  for (int i = 0; i < 2; ++i) {
    int r = (tid >> 4) + 32 * i, c4 = (tid & 15) * 4;
    float4 v = *(const float4*)(src + (size_t)(kt * 64 + r) * N + nt * 64 + c4);
    t[r * 65 + c4] = v.x; t[r * 65 + c4 + 1] = v.y; t[r * 65 + c4 + 2] = v.z; t[r * 65 + c4 + 3] = v.w;
  }
  __syncthreads();
  {
    int n = tid >> 3, k8 = (tid & 7) * 8;
    bf16x8 o;
#pragma unroll
    for (int j = 0; j < 8; ++j) o[j] = (short)f2bf(t[(k8 + j) * 65 + n]);
    *(bf16x8*)(dst + (size_t)(nt * 64 + n) * K + kt * 64 + k8) = o;
  }
  __syncthreads();
}
__device__ __forceinline__ int cvt_run(const float* src, int K, int N, bf16_t* dst, char* smem, int gbase) {
  const int nt = (K >> 6) * (N >> 6), G = gridDim.x;
  const int g0 = gbase + ((((int)blockIdx.x - gbase) % G) + G) % G;
  for (int g = g0; g < gbase + nt; g += G) cvt_tile(src, K, N, dst, g - gbase, smem);
  return gbase + nt;
}

__device__ void hyena_h2_phase(const Params& P, char* smem) {
  float* zs = (float*)smem;
  float* h1s = zs + 8 * 64;
  const int tid = threadIdx.x, wave = tid >> 6, lane = tid & 63;
  const float fq0 = P.hy_freq[lane], fq1 = P.hy_freq[64 + lane], b1 = P.hy_f_b1[lane], b2 = P.hy_f_b2[lane];
  for (int base = blockIdx.x * 8; base < 16640; base += gridDim.x * 8) {
    const int idx = base + wave;
    const int L = idx < LSEQ ? LSEQ : 256, n = idx < LSEQ ? idx : idx - LSEQ;
    float zv = 0.f;
    if (lane == 0) zv = (float)n / (float)(L - 1);
    else if (lane < 33) {
      int i = (lane - 1) & 15;
      float fr = 1e-4f + (float)i * ((15.f - 1e-4f) / 15.f);
      float w = (6.283185307179586f * (float)n) / (float)L;
      float a = fr * w;
      zv = lane < 17 ? cosf(a) : -sinf(a);
    }
    zs[wave * 64 + lane] = zv;
    __syncthreads();
    float acc = b1;
    for (int i = 0; i < 33; ++i) acc += zs[wave * 64 + i] * P.hy_f_w1[i * 64 + lane];
    h1s[wave * 64 + lane] = sinf(fq0 * acc);
    __syncthreads();
    float acc2 = b2;
    for (int i = 0; i < 64; ++i) acc2 += h1s[wave * 64 + i] * P.hy_f_w2[i * 64 + lane];
    float h2 = sinf(fq1 * acc2);
    if (idx < LSEQ) P.h2b[(size_t)n * 64 + lane] = f2bf(h2); else P.h2cb[(size_t)n * 64 + lane] = f2bf(h2);
    __syncthreads();
  }
}

__device__ void norm_phase(const float* xlat, const float* xctx, const float* nw, const float* modl, int chunk_shift, bf16_t* H, int nrows, int perm) {
  const int tid = threadIdx.x, wave = tid >> 6, lane = tid & 63;
  for (int row = blockIdx.x * 8 + wave; row < nrows; row += gridDim.x * 8) {
    const float* src = row < MLAT ? xlat + (size_t)row * 2048 : xctx + (size_t)(row - MLAT) * 2048;
    const int which = row < MLAT ? (row >> 14) : 2;
    float4 v[8]; float ss = 0.f;
#pragma unroll
    for (int i = 0; i < 8; ++i) {
      v[i] = *(const float4*)(src + (i * 64 + lane) * 4);
      ss += v[i].x * v[i].x + v[i].y * v[i].y + v[i].z * v[i].z + v[i].w * v[i].w;
    }
    ss = wave_sum(ss);
    const float rs = rsqrtf(ss * (1.f / 2048.f) + 1e-6f);
    int drow = row;
    if (perm && row < MLAT) { int t = row & (LSEQ - 1); drow = (row & ~(LSEQ - 1)) + (t & 63) * 256 + (t >> 6); }
    const float* sh = modl + which * 12288 + chunk_shift * 2048;
    const float* sc = sh + 2048;
#pragma unroll
    for (int i = 0; i < 8; ++i) {
      int col = (i * 64 + lane) * 4;
      float4 w = *(const float4*)(nw + col), s1 = *(const float4*)(sc + col), s0 = *(const float4*)(sh + col);
      float o0 = v[i].x * rs * w.x * (1.f + s1.x) + s0.x, o1 = v[i].y * rs * w.y * (1.f + s1.y) + s0.y;
      float o2 = v[i].z * rs * w.z * (1.f + s1.z) + s0.z, o3 = v[i].w * rs * w.w * (1.f + s1.w) + s0.w;
      uint2 u; u.x = pack2(o0, o1); u.y = pack2(o2, o3);
      *(uint2*)(H + (size_t)drow * 2048 + col) = u;
    }
  }
}

__device__ void final_norm_phase(float* xl, const float* w) {
  const int tid = threadIdx.x, wave = tid >> 6, lane = tid & 63;
  for (int row = blockIdx.x * 8 + wave; row < MLAT; row += gridDim.x * 8) {
    float* src = xl + (size_t)row * 2048;
    float4 v[8]; float ss = 0.f;
#pragma unroll
    for (int i = 0; i < 8; ++i) {
      v[i] = *(const float4*)(src + (i * 64 + lane) * 4);
      ss += v[i].x * v[i].x + v[i].y * v[i].y + v[i].z * v[i].z + v[i].w * v[i].w;
    }
    ss = wave_sum(ss);
    const float rs = rsqrtf(ss * (1.f / 2048.f) + 1e-6f);
#pragma unroll
    for (int i = 0; i < 8; ++i) {
      int col = (i * 64 + lane) * 4;
      float4 ww = *(const float4*)(w + col);
      float4 o = make_float4(v[i].x * rs * ww.x, v[i].y * rs * ww.y, v[i].z * rs * ww.z, v[i].w * rs * ww.w);
      *(float4*)(src + col) = o;
    }
  }
}

__device__ __forceinline__ void fft_fwd(float2* X, const float2* __restrict__ TW) {
  const int tid = threadIdx.x;
#pragma unroll 1
  for (int lq = 12; lq >= 0; lq -= 2) {
    const int q = 1 << lq, tws = 4096 >> lq;
#pragma unroll 2
    for (int i = 0; i < 8; ++i) {
      const int bidx = tid + NT * i, j = bidx & (q - 1), base = ((bidx >> lq) << (lq + 2)) + j;
      float2 a0 = X[base], a1 = X[base + q], a2 = X[base + 2 * q], a3 = X[base + 3 * q];
      float2 t0 = make_float2(a0.x + a2.x, a0.y + a2.y), t1 = make_float2(a0.x - a2.x, a0.y - a2.y);
      float2 t2 = make_float2(a1.x + a3.x, a1.y + a3.y), d = make_float2(a1.x - a3.x, a1.y - a3.y);
      float2 t3 = make_float2(d.y, -d.x);
      float2 y0 = make_float2(t0.x + t2.x, t0.y + t2.y), y1 = make_float2(t1.x + t3.x, t1.y + t3.y);
      float2 y2 = make_float2(t0.x - t2.x, t0.y - t2.y), y3 = make_float2(t1.x - t3.x, t1.y - t3.y);
      float2 w1 = TW[j * tws], w2 = TW[2 * j * tws], w3 = TW[3 * j * tws];
      X[base] = y0; X[base + q] = cmul(y1, w1); X[base + 2 * q] = cmul(y2, w2); X[base + 3 * q] = cmul(y3, w3);
    }
    __syncthreads();
  }
}
__device__ __forceinline__ void fft_inv(float2* X, const float2* __restrict__ TW) {
  const int tid = threadIdx.x;
#pragma unroll 1
  for (int lq = 0; lq <= 12; lq += 2) {
    const int q = 1 << lq, tws = 4096 >> lq;
#pragma unroll 2
    for (int i = 0; i < 8; ++i) {
      const int bidx = tid + NT * i, j = bidx & (q - 1), base = ((bidx >> lq) << (lq + 2)) + j;
      float2 w1 = TW[j * tws], w2 = TW[2 * j * tws], w3 = TW[3 * j * tws];
      float2 b0 = X[base], b1 = cmulc(X[base + q], w1), b2 = cmulc(X[base + 2 * q], w2), b3 = cmulc(X[base + 3 * q], w3);
      float2 t0 = make_float2(b0.x + b2.x, b0.y + b2.y), t1 = make_float2(b0.x - b2.x, b0.y - b2.y);
      float2 t2 = make_float2(b1.x + b3.x, b1.y + b3.y), d = make_float2(b1.x - b3.x, b1.y - b3.y);
      float2 t3 = make_float2(-d.y, d.x);
      X[base] = make_float2(t0.x + t2.x, t0.y + t2.y); X[base + q] = make_float2(t1.x + t3.x, t1.y + t3.y);
      X[base + 2 * q] = make_float2(t0.x - t2.x, t0.y - t2.y); X[base + 3 * q] = make_float2(t1.x - t3.x, t1.y - t3.y);
    }
    __syncthreads();
  }
}

__device__ __forceinline__ float conv3_at(const bf16_t* __restrict__ col, int n, int len, float w0, float w1, float w2, float bb) {
  float c = bf2f(col[n]);
  float p = n > 0 ? bf2f(col[n - 1]) : 0.f;
  float x = n < len - 1 ? bf2f(col[n + 1]) : 0.f;
  return bb + w0 * p + w1 * c + w2 * x;
}

__device__ void hyena_channel(const Params& P, int c, char* smem) {
  float2* X = (float2*)smem;
  float* red = (float*)(smem + 131072);
  const int tid = threadIdx.x;
  const float2* __restrict__ TW = P.tw;
  const float2* __restrict__ HF = P.half;
  const bf16_t* pv = P.RP + (size_t)c * MALL;
  const bf16_t* px1 = P.RP + (size_t)(1024 + c) * MALL;
  const bf16_t* px2 = P.RP + (size_t)(2048 + c) * MALL;
  const float* cw = P.hy_conv_w; const float* cb = P.hy_conv_b;
  const float vw0 = cw[c], vw1 = cw[3072 + c], vw2 = cw[6144 + c], vb = cb[c];
  const float aw0 = cw[1024 + c], aw1 = cw[3072 + 1024 + c], aw2 = cw[6144 + 1024 + c], ab = cb[1024 + c];
  const float bw0 = cw[2048 + c], bw1 = cw[3072 + 2048 + c], bw2 = cw[6144 + 2048 + c], bb = cb[2048 + c];
  const float dlo = -3.0701134573253944f, dhi = -15.350567286626972f;
  const float delta = fabsf(dlo + (dhi - dlo) * ((float)c / 1023.f));
  const float* taps = P.out;
  float2 K[32];
  float2* __restrict__ Rg = (float2*)(P.RA + (size_t)3 * MALL * 1024) + (size_t)blockIdx.x * (2 * LSEQ);
  float2* __restrict__ Zg = Rg + LSEQ;
#pragma unroll 2
  for (int i = 0; i < 32; ++i) {
    const int n = tid + NT * i;
    Zg[n] = make_float2(conv3_at(pv, n, LSEQ, vw0, vw1, vw2, vb), conv3_at(pv + LSEQ, n, LSEQ, vw0, vw1, vw2, vb));
  }
#pragma unroll 1
  for (int o = 0; o < 2; ++o) {
    const float* tl = taps + (size_t)(o * 2048 + c) * LSEQ;
    const float* th = taps + (size_t)(o * 2048 + 1024 + c) * LSEQ;
    const float bias = P.hy_bias[o * 1024 + c];
    float nrm = 0.f;
    __syncthreads();
#pragma unroll 2
    for (int i = 0; i < 32; ++i) {
      const int n = tid + NT * i;
      float lo = tl[n] * expf(-((float)n / 16383.f) * delta);
      float hi = n > 0 ? th[LSEQ - n] * expf(-((float)(LSEQ - n) / 16383.f) * delta) : 0.f;
      X[n] = make_float2(lo + hi, 0.f);
      nrm += fabsf(lo) + fabsf(hi);
    }
    const float norm = block_sum(nrm, red);
    fft_fwd(X, TW);
#pragma unroll
    for (int i = 0; i < 32; ++i) K[i] = X[tid + NT * i];
    __syncthreads();
#pragma unroll 4
    for (int i = 0; i < 32; ++i) X[tid + NT * i] = Zg[tid + NT * i];
    __syncthreads();
    fft_fwd(X, TW);
#pragma unroll
    for (int i = 0; i < 32; ++i) { const int n = tid + NT * i; X[n] = cmul(X[n], K[i]); }
    __syncthreads();
    fft_inv(X, TW);
#pragma unroll 4
    for (int i = 0; i < 32; ++i) Rg[tid + NT * i] = X[tid + NT * i];
    __syncthreads();
#pragma unroll 2
    for (int i = 0; i < 32; ++i) {
      const int n = tid + NT * i;
      float lo = tl[n] * expf(-((float)n / 16383.f) * delta);
      float hi = n > 0 ? th[LSEQ - n] * expf(-((float)(LSEQ - n) / 16383.f) * delta) : 0.f;
      float2 h = HF[n];
      float dd = lo - hi;
      X[n] = make_float2(dd * h.x, dd * h.y);
    }
    __syncthreads();
    fft_fwd(X, TW);
#pragma unroll
    for (int i = 0; i < 32; ++i) K[i] = X[tid + NT * i];
    __syncthreads();
#pragma unroll 4
    for (int i = 0; i < 32; ++i) { const int n = tid + NT * i; X[n] = cmul(Zg[n], HF[n]); }
    __syncthreads();
    fft_fwd(X, TW);
#pragma unroll
    for (int i = 0; i < 32; ++i) { const int n = tid + NT * i; X[n] = cmul(X[n], K[i]); }
    __syncthreads();
    fft_inv(X, TW);
    const float sc = 0.5f / (16384.f * norm);
#pragma unroll 2
    for (int i = 0; i < 32; ++i) {
      const int n = tid + NT * i;
      float2 t = cmulc(X[n], HF[n]);
      float2 rr = Rg[n], zz = Zg[n];
      float y0 = (rr.x + t.x) * sc + zz.x * bias;
      float y1 = (rr.y + t.y) * sc + zz.y * bias;
      if (o == 0) {
        Zg[n] = make_float2(conv3_at(px1, n, LSEQ, aw0, aw1, aw2, ab) * y0, conv3_at(px1 + LSEQ, n, LSEQ, aw0, aw1, aw2, ab) * y1);
      } else {
        float o0 = conv3_at(px2, n, LSEQ, bw0, bw1, bw2, bb) * y0;
        float o1 = conv3_at(px2 + LSEQ, n, LSEQ, bw0, bw1, bw2, bb) * y1;
        P.H[(size_t)n * 2048 + c] = f2bf(o0);
        P.H[(size_t)(LSEQ + n) * 2048 + c] = f2bf(o1);
      }
    }
    __syncthreads();
  }
}

__device__ void hyena_ctx_channel(const Params& P, int c, char* smem) {
  float* Kf = (float*)smem;
  float* u = Kf + 1024;
  float* z = u + 512;
  float* red = z + 512;
  const int tid = threadIdx.x, b = tid >> 8, t = tid & 255;
  const float dlo = -3.0701134573253944f, dhi = -15.350567286626972f;
  const float delta = fabsf(dlo + (dhi - dlo) * ((float)c / 1023.f));
  const float* cw = P.hy_conv_w; const float* cb = P.hy_conv_b;
  float nrm[2];
  __syncthreads();
  {
    const int o = b, n = t;
    float dec = expf(-((float)n / 255.f) * delta);
    float lo = P.tapsc[(size_t)(o * 2048 + c) * 256 + n] * dec;
    float hi = n > 0 ? P.tapsc[(size_t)(o * 2048 + 1024 + c) * 256 + n] * dec : 0.f;
    Kf[o * 512 + 256 + n] = lo;
    if (n > 0) Kf[o * 512 + 256 - n] = hi;
    float v = fabsf(lo) + fabsf(hi);
    v = wave_sum(v);
    if ((tid & 63) == 0) red[tid >> 6] = v;
  }
  const bf16_t* pv = P.RP + (size_t)c * MALL + MLAT + b * 256;
  const bf16_t* px1 = P.RP + (size_t)(1024 + c) * MALL + MLAT + b * 256;
  const bf16_t* px2 = P.RP + (size_t)(2048 + c) * MALL + MLAT + b * 256;
  u[b * 256 + t] = conv3_at(pv, t, 256, cw[c], cw[3072 + c], cw[6144 + c], cb[c]);
  __syncthreads();
  nrm[0] = red[0] + red[1] + red[2] + red[3];
  nrm[1] = red[4] + red[5] + red[6] + red[7];
  float acc = 0.f;
  for (int s = 0; s < 256; ++s) acc += Kf[256 + t - s] * u[b * 256 + s];
  float y1 = acc / nrm[0] + u[b * 256 + t] * P.hy_bias[c];
  float zz = conv3_at(px1, t, 256, cw[1024 + c], cw[3072 + 1024 + c], cw[6144 + 1024 + c], cb[1024 + c]) * y1;
  z[b * 256 + t] = zz;
  __syncthreads();
  acc = 0.f;
  for (int s = 0; s < 256; ++s) acc += Kf[512 + 256 + t - s] * z[b * 256 + s];
  float y2 = acc / nrm[1] + zz * P.hy_bias[1024 + c];
  float o2 = conv3_at(px2, t, 256, cw[2048 + c], cw[3072 + 2048 + c], cw[6144 + 2048 + c], cb[2048 + c]) * y2;
  P.H[(size_t)(MLAT + b * 256 + t) * 2048 + c] = f2bf(o2);
  __syncthreads();
}

__device__ void rwkv_scan_task(const Params& P, int task, char* smem) {
  const int tid = threadIdx.x, wave = tid >> 6, lane = tid & 63;
  const int qr = task & 3, dir = (task >> 2) & 1, h = (task >> 3) & 15, b = task >> 7;
  const bf16_t* prw = P.RP + (size_t)3072 * MALL;
  bf16_t* W2t = (bf16_t*)smem;
  bf16_t* A2t = W2t + 64 * 104;
  bf16_t* Aw = A2t + 64 * 104;
  bf16_t* Aa = Aw + 32 * 104;
  float* cst = (float*)(Aa + 32 * 104);
  float* kraw = cst + 320;
  float* Fdec = kraw + 2048;
  float* Fkd = Fdec + 2048;
  float* Fkka = Fkd + 2048;
  float* Fkk = Fkka + 2048;
  float* Fr = Fkk + 2048;
  float* Fv = Fr + 2048;
  float* ybuf = Fv + 512;
  bf16_t* yout = P.RA + (size_t)dir * MALL * 1024;
  __syncthreads();
  for (int i = tid; i < 96 * 64; i += NT) {
    int r = i >> 6, d = i & 63;
    W2t[d * 104 + r] = f2bf(P.rw_w2[(size_t)(dir * 96 + r) * 1024 + h * 64 + d]);
    A2t[d * 104 + r] = f2bf(P.rw_a2[(size_t)(dir * 96 + r) * 1024 + h * 64 + d]);
  }
  if (tid < 64) {
    cst[tid] = P.rw_w0[dir * 1024 + h * 64 + tid];
    cst[64 + tid] = P.rw_a0[dir * 1024 + h * 64 + tid];
    cst[128 + tid] = P.rw_k_k[h * 64 + tid];
    cst[192 + tid] = P.rw_k_a[h * 64 + tid];
    cst[256 + tid] = P.rw_r_k[h * 64 + tid];
  }
  float S[16];
#pragma unroll
  for (int i = 0; i < 16; ++i) S[i] = 0.f;
  __syncthreads();
#pragma unroll 1
  for (int ci = 0; ci < 520; ++ci) {
    for (int id = tid; id < 768; id += NT) {
      const int tok = id / 24, rem = id % 24, part = rem >> 3, d8 = (rem & 7) * 8;
      int pos, len; const int row = step_row(ci * 32 + tok, b, dir, pos, len);
      float v[8]; rw_shift8(prw, P.rw_mu, row, pos, len, part * 1024 + h * 64 + d8, v);
      if (part == 0) {
#pragma unroll
        for (int j = 0; j < 8; ++j) Fr[tok * 64 + d8 + j] = v[j];
      } else if (part == 1) {
#pragma unroll
        for (int j = 0; j < 8; ++j) kraw[tok * 64 + d8 + j] = v[j];
      } else if ((d8 >> 4) == qr) {
#pragma unroll
        for (int j = 0; j < 8; ++j) Fv[tok * 16 + (d8 & 15) + j] = v[j];
      }
    }
    for (int id = tid; id < 768; id += NT) {
      const int tok = id / 24, rem = id % 24, which = rem / 12, k8 = (rem % 12) * 8;
      int pos, len; const int row = step_row(ci * 32 + tok, b, dir, pos, len);
      float v[8]; rw_shift8(prw, P.rw_mu, row, pos, len, (which ? 3264 : 3072) + dir * 96 + k8, v);
      bf16x8 o;
      if (which == 0) {
#pragma unroll
        for (int j = 0; j < 8; ++j) o[j] = (short)f2bf(tanhf(v[j]));
        *(bf16x8*)(Aw + tok * 104 + k8) = o;
      } else {
#pragma unroll
        for (int j = 0; j < 8; ++j) o[j] = (short)f2bf(v[j]);
        *(bf16x8*)(Aa + tok * 104 + k8) = o;
      }
    }
    __syncthreads();
    {
      const int mat = wave >> 2, mt = (wave >> 1) & 1, np = wave & 1, fr = lane & 15, fq = lane >> 4;
      const bf16_t* As = mat ? Aa : Aw;
      const bf16_t* Bs = mat ? A2t : W2t;
#pragma unroll
      for (int nn = 0; nn < 2; ++nn) {
        const int nt = np * 2 + nn;
        f32x4 acc = {0.f, 0.f, 0.f, 0.f};
#pragma unroll
        for (int ks = 0; ks < 3; ++ks) {
          bf16x8 a = *(const bf16x8*)(As + (mt * 16 + fr) * 104 + ks * 32 + fq * 8);
          bf16x8 bb = *(const bf16x8*)(Bs + (nt * 16 + fr) * 104 + ks * 32 + fq * 8);
          acc = __builtin_amdgcn_mfma_f32_16x16x32_bf16(bb, a, acc, 0, 0, 0);
        }
        const int tok = mt * 16 + fr;
#pragma unroll
        for (int j = 0; j < 4; ++j) {
          const int d = nt * 16 + fq * 4 + j;
          if (mat == 0) {
            float xx = cst[d] + acc[j];
            Fdec[tok * 64 + d] = expf(-0.6065306597126334f * sigmoidf_(xx));
          } else {
            Fkka[tok * 64 + d] = sigmoidf_(cst[64 + d] + acc[j]);
          }
        }
      }
    }
    __syncthreads();
    {
      const int tok = tid >> 4, d4 = (tid & 15) * 4;
      float kkv[4], kd[4], av[4], ss = 0.f, bn = 0.f;
#pragma unroll
      for (int j = 0; j < 4; ++j) {
        const int d = d4 + j;
        float k = kraw[tok * 64 + d];
        av[j] = Fkka[tok * 64 + d];
        kkv[j] = k * cst[128 + d];
        ss += kkv[j] * kkv[j];
        kd[j] = k * (1.f + (av[j] - 1.f) * cst[192 + d]);
        bn += Fr[tok * 64 + d] * kd[j] * cst[256 + d];
      }
#pragma unroll
      for (int m = 8; m >= 1; m >>= 1) { ss += __shfl_xor(ss, m); bn += __shfl_xor(bn, m); }
      const float inv = rsqrtf(fmaxf(ss, 1e-24f));
#pragma unroll
      for (int j = 0; j < 4; ++j) {
        const int d = d4 + j;
        float kk = kkv[j] * inv;
        Fkk[tok * 64 + d] = kk;
        Fkd[tok * 64 + d] = kd[j];
        Fkka[tok * 64 + d] = kk * av[j];
      }
      if (qr == 0 && (tid & 15) == 0) {
        int pos, len; const int row = step_row(ci * 32 + tok, b, dir, pos, len);
        P.bonus[((size_t)dir * MALL + row) * 16 + h] = bn;
      }
    }
    __syncthreads();
    if (wave == 0) {
      const int v = lane >> 2, q = lane & 3;
#pragma unroll 2
      for (int j = 0; j < 32; ++j) {
        const float4* kkp = (const float4*)(Fkk + j * 64 + 16 * q);
        const float4* dcp = (const float4*)(Fdec + j * 64 + 16 * q);
        const float4* kap = (const float4*)(Fkka + j * 64 + 16 * q);
        const float4* kdp = (const float4*)(Fkd + j * 64 + 16 * q);
        const float4* rp = (const float4*)(Fr + j * 64 + 16 * q);
        float sa = 0.f;
#pragma unroll
        for (int i = 0; i < 4; ++i) { float4 k4 = kkp[i]; sa += S[4 * i] * k4.x + S[4 * i + 1] * k4.y + S[4 * i + 2] * k4.z + S[4 * i + 3] * k4.w; }
        sa += __shfl_xor(sa, 1); sa += __shfl_xor(sa, 2);
        const float vv = Fv[j * 16 + v];
        float y = 0.f;
#pragma unroll
        for (int i = 0; i < 4; ++i) {
          float4 dc = dcp[i], ka = kap[i], kd = kdp[i], r4 = rp[i];
          S[4 * i] = S[4 * i] * dc.x - sa * ka.x + vv * kd.x;
          S[4 * i + 1] = S[4 * i + 1] * dc.y - sa * ka.y + vv * kd.y;
          S[4 * i + 2] = S[4 * i + 2] * dc.z - sa * ka.z + vv * kd.z;
          S[4 * i + 3] = S[4 * i + 3] * dc.w - sa * ka.w + vv * kd.w;
          y += S[4 * i] * r4.x + S[4 * i + 1] * r4.y + S[4 * i + 2] * r4.z + S[4 * i + 3] * r4.w;
        }
        y += __shfl_xor(y, 1); y += __shfl_xor(y, 2);
        if (q == 0) ybuf[j * 16 + v] = y;
      }
    }
    __syncthreads();
    {
      const int tok = tid >> 4, vv = tid & 15;
      int pos, len; const int row = step_row(ci * 32 + tok, b, dir, pos, len);
      yout[(size_t)row * 1024 + h * 64 + qr * 16 + vv] = f2bf(ybuf[tok * 16 + vv]);
    }
  }
  __syncthreads();
}

__device__ void rwkv_readout_phase(const Params& P) {
  const int tid = threadIdx.x, wave = tid >> 6, lane = tid & 63;
  const bf16_t* prw = P.RP + (size_t)3072 * MALL;
  const bf16_t* yf = P.RA; const bf16_t* yb = P.RA + (size_t)MALL * 1024; const bf16_t* g = P.RA + (size_t)2 * MALL * 1024;
  for (int item = blockIdx.x * 8 + wave; item < MALL * 4; item += gridDim.x * 8) {
    const int row = item >> 2, h = (item & 3) * 4 + (lane >> 4), d4 = (lane & 15) * 4, col = h * 64 + d4;
    int pos, len; row_info(row, pos, len);
    uint2 uf = *(const uint2*)(yf + (size_t)row * 1024 + col), ub = *(const uint2*)(yb + (size_t)row * 1024 + col);
    float y[4];
    y[0] = bf2f(uf.x & 0xffff) + bf2f(ub.x & 0xffff); y[1] = bf2f(uf.x >> 16) + bf2f(ub.x >> 16);
    y[2] = bf2f(uf.y & 0xffff) + bf2f(ub.y & 0xffff); y[3] = bf2f(uf.y >> 16) + bf2f(ub.y >> 16);
    float s = y[0] + y[1] + y[2] + y[3];
#pragma unroll
    for (int m = 8; m >= 1; m >>= 1) s += __shfl_xor(s, m);
    const float mean = s * (1.f / 64.f);
    float vs = 0.f;
#pragma unroll
    for (int j = 0; j < 4; ++j) { float dd = y[j] - mean; vs += dd * dd; }
#pragma unroll
    for (int m = 8; m >= 1; m >>= 1) vs += __shfl_xor(vs, m);
    const float rs = rsqrtf(vs * (1.f / 64.f) + 64e-5f);
    const float bn = P.bonus[(size_t)row * 16 + h] + P.bonus[((size_t)MALL + row) * 16 + h];
    const bf16_t* pp = prw + (size_t)row * 3712 + 2048 + col;
    uint2 cu = *(const uint2*)pp, z2 = make_uint2(0, 0);
    uint2 pu = pos > 0 ? *(const uint2*)(pp - 3712) : z2;
    uint2 nu = pos < len - 1 ? *(const uint2*)(pp + 3712) : z2;
    float cv[4] = {bf2f(cu.x & 0xffff), bf2f(cu.x >> 16), bf2f(cu.y & 0xffff), bf2f(cu.y >> 16)};
    float pv[4] = {bf2f(pu.x & 0xffff), bf2f(pu.x >> 16), bf2f(pu.y & 0xffff), bf2f(pu.y >> 16)};
    float nv[4] = {bf2f(nu.x & 0xffff), bf2f(nu.x >> 16), bf2f(nu.y & 0xffff), bf2f(nu.y >> 16)};
    uint2 gu = *(const uint2*)(g + (size_t)row * 1024 + col);
    float gv[4] = {bf2f(gu.x & 0xffff), bf2f(gu.x >> 16), bf2f(gu.y & 0xffff), bf2f(gu.y >> 16)};
    float o[4];
#pragma unroll
    for (int j = 0; j < 4; ++j) {
      float vsh = cv[j] + (0.5f * (pv[j] + nv[j]) - cv[j]) * P.rw_mu[2048 + col + j];
      float ln = (y[j] - mean) * rs * P.rw_ln_w[col + j] + P.rw_ln_b[col + j];
      o[j] = (ln + bn * vsh) * gv[j];
    }
    uint2 u; u.x = pack2(o[0], o[1]); u.y = pack2(o[2], o[3]);
    *(uint2*)(P.H + (size_t)row * 2048 + 1024 + col) = u;
  }
}

__device__ void hgrn2_scan_wave(const Params& P, int wt) {
  const int lane = threadIdx.x & 63;
  const int vg = wt & 31, chain = wt >> 5, dir = chain & 1, h = (chain >> 1) & 7, b = chain >> 4;
  const bf16_t* p1 = P.RP;
  bf16_t* oout = P.RA + (size_t)dir * MALL * 1024;
  float S[2][4];
#pragma unroll
  for (int e = 0; e < 2; ++e)
#pragma unroll
    for (int v = 0; v < 4; ++v) S[e][v] = 0.f;
  const int vsel = ((lane >> 5) & 1) * 2 + ((lane >> 4) & 1);
#pragma unroll 1
  for (int s0 = 0; s0 < 16640; s0 += 8) {
    unsigned qv[8], kv[8]; uint2 vv[8]; int rows[8];
#pragma unroll
    for (int u = 0; u < 8; ++u) {
      int pos, len; rows[u] = step_row(s0 + u, b, dir, pos, len);
      const bf16_t* rp = p1 + (size_t)rows[u] * 7168;
      qv[u] = *(const unsigned*)(rp + h * 128 + 2 * lane);
      kv[u] = *(const unsigned*)(rp + 1024 + dir * 1024 + h * 128 + 2 * lane);
      vv[u] = *(const uint2*)(rp + 3072 + h * 128 + 4 * vg);
    }
#pragma unroll
    for (int u = 0; u < 8; ++u) {
      const float q0 = bf2f(qv[u] & 0xffff), q1 = bf2f(qv[u] >> 16);
      const float k0 = bf2f(kv[u] & 0xffff), k1 = bf2f(kv[u] >> 16);
      const float f0 = 1.f - k0, f1 = 1.f - k1;
      const float v4[4] = {bf2f(vv[u].x & 0xffff), bf2f(vv[u].x >> 16), bf2f(vv[u].y & 0xffff), bf2f(vv[u].y >> 16)};
      float po[4];
#pragma unroll
      for (int v = 0; v < 4; ++v) {
        S[0][v] = f0 * S[0][v] + k0 * v4[v];
        S[1][v] = f1 * S[1][v] + k1 * v4[v];
        po[v] = q0 * S[0][v] + q1 * S[1][v];
      }
      const bool hi32 = lane & 32;
      float s0v = hi32 ? po[0] : po[2], s1v = hi32 ? po[1] : po[3];
      float k0v = hi32 ? po[2] : po[0], k1v = hi32 ? po[3] : po[1];
      k0v += __shfl_xor(s0v, 32); k1v += __shfl_xor(s1v, 32);
      const bool hi16 = lane & 16;
      float snd = hi16 ? k0v : k1v, kp = hi16 ? k1v : k0v;
      kp += __shfl_xor(snd, 16);
      kp += __shfl_xor(kp, 8); kp += __shfl_xor(kp, 4); kp += __shfl_xor(kp, 2); kp += __shfl_xor(kp, 1);
      if ((lane & 15) == 0) oout[(size_t)rows[u] * 1024 + h * 128 + 4 * vg + vsel] = f2bf(kp);
    }
  }
}

__device__ void rglru_task(const Params& P, int task, char* smem) {
  const int tid = threadIdx.x, wave = tid >> 6, lane = tid & 63;
  const int hd = task & 15, dir = (task >> 4) & 1, b = task >> 5;
  const bf16_t* p1 = P.RP;
  bf16_t* hout = P.RA + (size_t)(2 + dir) * MALL * 1024;
  bf16_t* Bt = (bf16_t*)smem;
  bf16_t* At = Bt + 128 * 72;
  float* xbf = (float*)(At + 64 * 72);
  float* Ga = xbf + 4096;
  float* Gu = Ga + 4096;
  float* cst = Gu + 4096;
  __syncthreads();
  for (int i = tid; i < 64 * 128; i += NT) {
    int k = i >> 7, n = i & 127;
    float w = n < 64 ? P.rg_wa[((size_t)(dir * 16 + hd) * 64 + k) * 64 + n] : P.rg_wx[((size_t)(dir * 16 + hd) * 64 + k) * 64 + (n - 64)];
    Bt[n * 72 + k] = f2bf(w);
  }
  if (tid < 64) {
    cst[tid] = P.rg_ba[(dir * 16 + hd) * 64 + tid];
    cst[64 + tid] = P.rg_bx[(dir * 16 + hd) * 64 + tid];
    float lam = P.rg_lam[dir * 1024 + hd * 64 + tid];
    cst[128 + tid] = 8.f * log1pf(expf(-lam));
    for (int k = 0; k < 4; ++k) cst[192 + k * 64 + tid] = P.rg_conv_w[k * 1024 + hd * 64 + tid];
    cst[448 + tid] = P.rg_conv_b[hd * 64 + tid];
  }
  float hstate = 0.f;
  __syncthreads();
#pragma unroll 1
  for (int ci = 0; ci < 260; ++ci) {
    int pos0, len; const int row_first = step_row(ci * 64, b, dir, pos0, len);
    const int rbase = dir ? row_first - 63 : row_first;
    const int pbase = dir ? pos0 - 63 : pos0;
    for (int id = tid; id < 64 * 8; id += NT) {
      const int tk = id >> 3, c8 = (id & 7) * 8;
      const int pos = pbase + tk;
      const bf16_t* rp = p1 + (size_t)(rbase + tk) * 7168 + 5120 + hd * 64 + c8;
      float acc[8];
#pragma unroll
      for (int j = 0; j < 8; ++j) acc[j] = cst[448 + c8 + j];
#pragma unroll
      for (int k = 0; k < 4; ++k) {
        const int pp = pos + k - 2;
        if (pp >= 0 && pp < len) {
          bf16x8 xv = *(const bf16x8*)(rp + (ptrdiff_t)(k - 2) * 7168);
#pragma unroll
          for (int j = 0; j < 8; ++j) acc[j] += bf2f((bf16_t)xv[j]) * cst[192 + k * 64 + c8 + j];
        }
      }
      bf16x8 o;
#pragma unroll
      for (int j = 0; j < 8; ++j) { o[j] = (short)f2bf(acc[j]); xbf[tk * 64 + c8 + j] = acc[j]; }
      *(bf16x8*)(At + tk * 72 + c8) = o;
    }
    __syncthreads();
    {
      const int mt = wave >> 1, nh = wave & 1, fr = lane & 15, fq = lane >> 4;
#pragma unroll
      for (int nn = 0; nn < 4; ++nn) {
        const int nt = nh * 4 + nn;
        f32x4 acc = {0.f, 0.f, 0.f, 0.f};
#pragma unroll
        for (int ks = 0; ks < 2; ++ks) {
          bf16x8 a = *(const bf16x8*)(At + (mt * 16 + fr) * 72 + ks * 32 + fq * 8);
          bf16x8 bb = *(const bf16x8*)(Bt + (nt * 16 + fr) * 72 + ks * 32 + fq * 8);
          acc = __builtin_amdgcn_mfma_f32_16x16x32_bf16(bb, a, acc, 0, 0, 0);
        }
        const int tk = mt * 16 + fr;
#pragma unroll
        for (int j = 0; j < 4; ++j) {
          const int n = nt * 16 + fq * 4 + j;
          if (n < 64) Ga[tk * 64 + n] = sigmoidf_(acc[j] + cst[n]);
          else Gu[tk * 64 + n - 64] = sigmoidf_(acc[j] + cst[64 + n - 64]);
        }
      }
    }
    __syncthreads();
    for (int id = tid; id < 4096; id += NT) {
      const int j = id & 63;
      const float ra = Ga[id], ix = Gu[id];
      const float log_a = -ra * cst[128 + j];
      Ga[id] = expf(log_a);
      Gu[id] = sqrtf(-expm1f(2.f * log_a)) * ix * xbf[id];
    }
    __syncthreads();
    if (wave == 0) {
#pragma unroll 4
      for (int s = 0; s < 64; ++s) {
        const int tk = dir ? 63 - s : s;
        hstate = Ga[tk * 64 + lane] * hstate + Gu[tk * 64 + lane];
        xbf[tk * 64 + lane] = hstate;
      }
    }
    __syncthreads();
    for (int id = tid; id < 4096; id += NT) {
      const int tk = id >> 6, j = id & 63;
      hout[(size_t)(rbase + tk) * 1024 + hd * 64 + j] = f2bf(xbf[id]);
    }
    __syncthreads();
  }
}

__device__ void l1_readout_phase(const Params& P) {
  const int tid = threadIdx.x, wave = tid >> 6, lane = tid & 63;
  const bf16_t* p1 = P.RP;
  const bf16_t* of = P.RA; const bf16_t* ob = P.RA + (size_t)MALL * 1024;
  const bf16_t* hf = P.RA + (size_t)2 * MALL * 1024; const bf16_t* hb = P.RA + (size_t)3 * MALL * 1024;
  for (int item = blockIdx.x * 8 + wave; item < MLAT * 8; item += gridDim.x * 8) {
    const int row = item >> 3, part = item & 7;
    if (part < 4) {
      const int col = part * 256 + lane * 4;
      uint2 a = *(const uint2*)(of + (size_t)row * 1024 + col), bq = *(const uint2*)(ob + (size_t)row * 1024 + col);
      float o[4] = {bf2f(a.x & 0xffff) + bf2f(bq.x & 0xffff), bf2f(a.x >> 16) + bf2f(bq.x >> 16),
                    bf2f(a.y & 0xffff) + bf2f(bq.y & 0xffff), bf2f(a.y >> 16) + bf2f(bq.y >> 16)};
      float ss = o[0] * o[0] + o[1] * o[1] + o[2] * o[2] + o[3] * o[3];
#pragma unroll
      for (int m = 16; m >= 1; m >>= 1) ss += __shfl_xor(ss, m);
      const float rs = rsqrtf(ss * (1.f / 128.f) + 1e-6f);
      uint2 gu = *(const uint2*)(p1 + (size_t)row * 7168 + 4096 + col);
      float gv[4] = {bf2f(gu.x & 0xffff), bf2f(gu.x >> 16), bf2f(gu.y & 0xffff), bf2f(gu.y >> 16)};
      float r[4];
#pragma unroll
      for (int j = 0; j < 4; ++j) r[j] = o[j] * rs * P.hg_norm_w[col + j] * gv[j];
      uint2 u; u.x = pack2(r[0], r[1]); u.y = pack2(r[2], r[3]);
      *(uint2*)(P.H + (size_t)row * 2048 + col) = u;
    } else {
      const int col = (part - 4) * 256 + lane * 4;
      uint2 a = *(const uint2*)(hf + (size_t)row * 1024 + col), bq = *(const uint2*)(hb + (size_t)row * 1024 + col);
      uint2 gu = *(const uint2*)(p1 + (size_t)row * 7168 + 6144 + col);
      float r0 = (bf2f(a.x & 0xffff) + bf2f(bq.x & 0xffff)) * bf2f(gu.x & 0xffff);
      float r1 = (bf2f(a.x >> 16) + bf2f(bq.x >> 16)) * bf2f(gu.x >> 16);
      float r2 = (bf2f(a.y & 0xffff) + bf2f(bq.y & 0xffff)) * bf2f(gu.y & 0xffff);
      float r3 = (bf2f(a.y >> 16) + bf2f(bq.y >> 16)) * bf2f(gu.y >> 16);
      uint2 u; u.x = pack2(r0, r1); u.y = pack2(r2, r3);
      *(uint2*)(P.H + (size_t)row * 2048 + 1024 + col) = u;
    }
  }
}

__global__ void __launch_bounds__(NT) mega(Params P) {
  extern __shared__ __attribute__((aligned(16))) char smem[];
  cg::grid_group grid = cg::this_grid();
  const int G = gridDim.x, bid = blockIdx.x, tid = threadIdx.x;
  const float* mod0 = P.mod; const float* mod1 = P.mod + 3 * 12288;

  for (int t = bid; t < 192; t += G) adaln_task(P, smem, t);
  {
    int gb = 192;
    gb = cvt_run(P.ev_w_in, 2048, 6784, P.w_in_t, smem, gb);
    gb = cvt_run(P.ev_w_out, 2048, 2048, P.w_out_t, smem, gb);
    gb = cvt_run(P.mlp_w1, 2048, 8192, P.w1_t, smem, gb);
    gb = cvt_run(P.mlp_w2, 8192, 2048, P.w2_t, smem, gb);
    gb = cvt_run(P.hy_f_w3, 64, 4096, P.w3t, smem, gb);
    gb = cvt_run(P.rw_g2, 256, 1024, P.g2t, smem, gb);
  }
  hyena_h2_phase(P, smem);
  for (int i = bid * NT + tid; i < 32768; i += G * NT) {
    if (i < 16384) { float s, c; sincospif(-(float)i / 8192.f, &s, &c); P.tw[i] = make_float2(c, s); }
    else { int n = i - 16384; float s, c; sincospif(-(float)n / 16384.f, &s, &c); P.half[n] = make_float2(c, s); }
  }
  grid.sync();
  norm_phase(P.x, P.ctx, P.norm_w, mod0, 0, P.H, MALL, 0);
  grid.sync();
  {
    int gb = 0;
    ALoadPlain aH{P.H, 2048};
    gb = gemm_run<true>(aH, P.w_in_t, 2048, MALL, 3072, EpTransBf16{P.RP, (size_t)MALL}, smem, gb);
    gb = gemm_run<false>(aH, P.w_in_t + (size_t)3072 * 2048, 2048, MALL, 3712, EpBf16{P.RP + (size_t)3072 * MALL, 3712}, smem, gb);
    gb = gemm_run<true>(ALoadPlain{P.h2b, 64}, P.w3t, 64, LSEQ, 4096, EpTransF32{P.out, (size_t)LSEQ}, smem, gb);
    gb = gemm_run<true>(ALoadPlain{P.h2cb, 64}, P.w3t, 64, 256, 4096, EpTransF32{P.tapsc, 256}, smem, gb);
  }
  grid.sync();
  for (int c = bid; c < 1024; c += G) hyena_channel(P, c, smem);
  for (int c = bid; c < 1024; c += G) hyena_ctx_channel(P, c, smem);
  gemm_run<false>(ALoadG{P.RP + (size_t)3072 * MALL, P.rw_mu}, P.g2t, 256, MALL, 1024, EpBf16{P.RA + (size_t)2 * MALL * 1024, 1024}, smem, 0);
  grid.sync();
  for (int t = bid; t < 256; t += G) rwkv_scan_task(P, t, smem);
  grid.sync();
  rwkv_readout_phase(P);
  grid.sync();
  gemm_run<false>(ALoadPlain{P.H, 2048}, P.w_out_t, 2048, MALL, 2048, EpResid{P.x, P.ctx, P.out, P.xc, mod0, 2, 0}, smem, 0);
  grid.sync();
  norm_phase(P.out, P.xc, P.norm_w + 2048, mod0, 3, P.H, MALL, 0);
  {
    int gb = 0;
    gb = cvt_run(P.od_w_in, 2048, 7168, P.w_in_t, smem, gb);
    gb = cvt_run(P.od_w_out, 2048, 2048, P.w_out_t, smem, gb);
  }
  grid.sync();
  gemm_run<false>(ALoadPlain{P.H, 2048}, P.w1_t, 2048, MALL, 8192, EpSqRelu{P.RP, 8192}, smem, 0);
  grid.sync();
  gemm_run<false>(ALoadPlain{P.RP, 8192}, P.w2_t, 8192, MALL, 2048, EpResid{P.out, P.xc, P.out, P.xc, mod0, 5, 0}, smem, 0);
  grid.sync();
  norm_phase(P.out, P.xc, P.norm_w + 4096, mod1, 0, P.H, MALL, 1);
  {
    int gb = 0;
    gb = cvt_run(P.mlp_w1 + (size_t)2048 * 8192, 2048, 8192, P.w1_t, smem, gb);
    gb = cvt_run(P.mlp_w2 + (size_t)2048 * 8192, 8192, 2048, P.w2_t, smem, gb);
  }
  grid.sync();
  gemm_run<false>(ALoadPlain{P.H, 2048}, P.w_in_t, 2048, MALL, 7168, EpIn1{P.RP, P.hg_lb}, smem, 0);
  grid.sync();
  for (int t = bid; t < 192; t += G) {
    if (t < 128) hgrn2_scan_wave(P, t * 8 + (tid >> 6));
    else rglru_task(P, t - 128, smem);
  }
  grid.sync();
  l1_readout_phase(P);
  grid.sync();
  gemm_run<false>(ALoadPlain{P.H, 2048}, P.w_out_t, 2048, MLAT, 2048, EpResid{P.out, P.xc, P.out, P.xc, mod1, 2, 1}, smem, 0);
  grid.sync();
  norm_phase(P.out, P.xc, P.norm_w + 6144, mod1, 3, P.H, MLAT, 0);
  grid.sync();
  gemm_run<false>(ALoadPlain{P.H, 2048}, P.w1_t, 2048, MLAT, 8192, EpSqRelu{P.RP, 8192}, smem, 0);
  grid.sync();
  gemm_run<false>(ALoadPlain{P.RP, 8192}, P.w2_t, 8192, MLAT, 2048, EpResid{P.out, P.xc, P.out, P.xc, mod1, 5, 0}, smem, 0);
  grid.sync();
  final_norm_phase(P.out, P.final_norm_w);
}

extern "C" void kernel_launch(void* const* d_in, const int* in_sizes, int n_in, void* d_out, int out_size,
                              void* d_ws, size_t ws_size, hipStream_t stream) {
  constexpr size_t kDynLds = 131072 + 1024;
  static int grid_blocks = 0;
  if (!grid_blocks) {
    hipFuncSetAttribute((const void*)mega, hipFuncAttributeMaxDynamicSharedMemorySize, (int)kDynLds);
    int dev = 0, cus = 0, per_cu = 0;
    hipGetDevice(&dev);
    hipDeviceGetAttribute(&cus, hipDeviceAttributeMultiprocessorCount, dev);
    hipOccupancyMaxActiveBlocksPerMultiprocessor(&per_cu, mega, NT, kDynLds);
    if (per_cu < 1) per_cu = 1;
    grid_blocks = cus;
  }
  Params p{};
  const float* const* in = (const float* const*)d_in;
  p.x = in[0]; p.c = in[1]; p.ctx = in[2]; p.c_ctx = in[3]; p.ada_w = in[4]; p.ada_b = in[5]; p.norm_w = in[6];
  p.mlp_w1 = in[7]; p.mlp_w2 = in[8]; p.final_norm_w = in[9]; p.ev_w_in = in[10]; p.ev_w_out = in[11];
  p.hy_conv_w = in[12]; p.hy_conv_b = in[13]; p.hy_f_w1 = in[14]; p.hy_f_b1 = in[15]; p.hy_f_w2 = in[16]; p.hy_f_b2 = in[17];
  p.hy_f_w3 = in[18]; p.hy_freq = in[19]; p.hy_bias = in[20]; p.rw_mu = in[21]; p.rw_w0 = in[22]; p.rw_w2 = in[23];
  p.rw_a0 = in[24]; p.rw_a2 = in[25]; p.rw_g2 = in[26]; p.rw_k_k = in[27]; p.rw_k_a = in[28]; p.rw_r_k = in[29];
  p.rw_ln_w = in[30]; p.rw_ln_b = in[31]; p.od_w_in = in[32]; p.od_w_out = in[33]; p.hg_lb = in[34]; p.hg_norm_w = in[35];
  p.rg_conv_w = in[36]; p.rg_conv_b = in[37]; p.rg_wa = in[38]; p.rg_ba = in[39]; p.rg_wx = in[40]; p.rg_bx = in[41]; p.rg_lam = in[42];
  p.out = (float*)d_out;
  char* ws = (char*)d_ws;
  p.mod = (float*)(ws);
  p.tw = (float2*)(ws + 512 * 1024);
  p.half = (float2*)(ws + 640 * 1024);
  p.h2b = (bf16_t*)(ws + 1 * MiB);
  p.h2cb = (bf16_t*)(ws + 3 * MiB);
  p.tapsc = (float*)(ws + 4 * MiB);
  p.xc = (float*)(ws + 8 * MiB);
  p.bonus = (float*)(ws + 12 * MiB);
  p.w3t = (bf16_t*)(ws + 17 * MiB);
  p.g2t = (bf16_t*)(ws + 17 * MiB + 512 * 1024);
  p.w_in_t = (bf16_t*)(ws + 24 * MiB);
  p.w_out_t = (bf16_t*)(ws + 52 * MiB);
  p.w1_t = (bf16_t*)(ws + 60 * MiB);
  p.w2_t = (bf16_t*)(ws + 92 * MiB);
  p.H = (bf16_t*)(ws + 124 * MiB);
  p.RP = (bf16_t*)(ws + 254 * MiB);
  p.RA = (bf16_t*)(ws + 709 * MiB);
  void* args[] = {&p};
  hipError_t e = hipLaunchCooperativeKernel((void*)mega, dim3(grid_blocks), dim3(NT), args, kDynLds, stream);
  if (e != hipSuccess) fprintf(stderr, "coop launch failed: %s\n", hipGetErrorString(e));
}
```

```cpp
#include <hip/hip_runtime.h>
#include <hip/hip_cooperative_groups.h>
#include <cstdio>
namespace cg = cooperative_groups;

typedef unsigned short bf16_t;
typedef short bf16x8 __attribute__((ext_vector_type(8)));
typedef float f32x4 __attribute__((ext_vector_type(4)));

#define NT 512
#define MLAT 32768
#define MALL 33280
#define LSEQ 16384
#define MiB (1048576ull)

struct Params {
  const float *x, *c, *ctx, *c_ctx, *ada_w, *ada_b, *norm_w, *mlp_w1, *mlp_w2, *final_norm_w;
  const float *ev_w_in, *ev_w_out, *hy_conv_w, *hy_conv_b, *hy_f_w1, *hy_f_b1, *hy_f_w2, *hy_f_b2, *hy_f_w3, *hy_freq, *hy_bias;
  const float *rw_mu, *rw_w0, *rw_w2, *rw_a0, *rw_a2, *rw_g2, *rw_k_k, *rw_k_a, *rw_r_k, *rw_ln_w, *rw_ln_b;
  const float *od_w_in, *od_w_out, *hg_lb, *hg_norm_w, *rg_conv_w, *rg_conv_b, *rg_wa, *rg_ba, *rg_wx, *rg_bx, *rg_lam;
  float* out;
  float* mod; float2* tw; float2* half; bf16_t* h2b; bf16_t* h2cb; float* tapsc; float* xc; float* bonus; bf16_t* w3t; bf16_t* g2t; float* rgsum; int* hyq; unsigned* xbar;
  bf16_t *w_in_t, *w_out_t, *w1_t, *w2_t;
  bf16_t* H;
  bf16_t* RP;
  bf16_t* RA;
};

__device__ __forceinline__ int tid_() { int t = threadIdx.x; asm volatile("" : "+v"(t)); return t; }
__device__ __forceinline__ float bf2f(bf16_t v) { return __uint_as_float(((unsigned)v) << 16); }
__device__ __forceinline__ unsigned pack2(float a, float b) { unsigned r; asm("v_cvt_pk_bf16_f32 %0, %1, %2" : "=v"(r) : "v"(a), "v"(b)); return r; }
__device__ __forceinline__ bf16_t f2bf(float f) { return (bf16_t)(pack2(f, f) & 0xffffu); }
__device__ __forceinline__ float sigmoidf_(float x) { return 1.f / (1.f + expf(-x)); }
__device__ __forceinline__ float siluf_(float x) { return x / (1.f + expf(-x)); }
__device__ __forceinline__ float fsig(float x) { return __builtin_amdgcn_rcpf(1.f + __expf(-x)); }
__device__ __forceinline__ float gelu_tanh_(float x) { return 0.5f * x * (1.f + tanhf(0.7978845608f * (x + 0.044715f * x * x * x))); }
__device__ __forceinline__ float2 cmul(float2 a, float2 b) { return make_float2(a.x * b.x - a.y * b.y, a.x * b.y + a.y * b.x); }
__device__ __forceinline__ float2 cmulc(float2 a, float2 b) { return make_float2(a.x * b.x + a.y * b.y, a.y * b.x - a.x * b.y); }
__device__ __forceinline__ void unpack8(bf16x8 v, float* o) {
#pragma unroll
  for (int j = 0; j < 8; ++j) o[j] = bf2f((bf16_t)v[j]);
}
__device__ __forceinline__ void row_info(int row, int& pos, int& len) {
  if (row < MLAT) { pos = row & (LSEQ - 1); len = LSEQ; } else { pos = (row - MLAT) & 255; len = 256; }
}
__device__ __forceinline__ int step_row(int s, int b, int dir, int& pos, int& len) {
  if (s < 256) { len = 256; pos = dir ? 255 - s : s; return MLAT + b * 256 + pos; }
  len = LSEQ; int ls = s - 256; pos = dir ? LSEQ - 1 - ls : ls; return b * LSEQ + pos;
}
__device__ __forceinline__ float wave_sum(float v) {
#pragma unroll
  for (int m = 32; m >= 1; m >>= 1) v += __shfl_xor(v, m);
  return v;
}
__device__ __forceinline__ float block_sum(float v, float* red) {
  v = wave_sum(v);
  __syncthreads();
  if ((tid_() & 63) == 0) red[tid_() >> 6] = v;
  __syncthreads();
  float s = 0.f;
#pragma unroll
  for (int i = 0; i < 8; ++i) s += red[i];
  __syncthreads();
  return s;
}

__device__ __forceinline__ void rw_shift8(const bf16_t* __restrict__ prw, const float* __restrict__ mu, int row, int pos, int len, int c, float* o) {
  const bf16_t* p = prw + (size_t)row * 3712 + c;
  bf16x8 cur = *(const bf16x8*)p;
  bf16x8 z = {0, 0, 0, 0, 0, 0, 0, 0};
  bf16x8 prv = pos > 0 ? *(const bf16x8*)(p - 3712) : z;
  bf16x8 nxt = pos < len - 1 ? *(const bf16x8*)(p + 3712) : z;
  float4 m0 = *(const float4*)(mu + c), m1 = *(const float4*)(mu + c + 4);
  float mm[8] = {m0.x, m0.y, m0.z, m0.w, m1.x, m1.y, m1.z, m1.w};
#pragma unroll
  for (int j = 0; j < 8; ++j) {
    float cc = bf2f((bf16_t)cur[j]), pp = bf2f((bf16_t)prv[j]), nn = bf2f((bf16_t)nxt[j]);
    o[j] = cc + (0.5f * (pp + nn) - cc) * mm[j];
  }
}

struct ALoadPlain {
  const bf16_t* A; size_t lda;
  __device__ __forceinline__ bf16x8 operator()(int row, int k) const { return *(const bf16x8*)(A + (size_t)row * lda + k); }
};
struct ALoadG {
  const bf16_t* prw; const float* mu;
  __device__ __forceinline__ bf16x8 operator()(int row, int k) const {
    int pos, len; row_info(row, pos, len);
    float v[8]; rw_shift8(prw, mu, row, pos, len, 3456 + k, v);
    bf16x8 r;
#pragma unroll
    for (int j = 0; j < 8; ++j) r[j] = (short)f2bf(sigmoidf_(v[j]));
    return r;
  }
};

template <bool TRANS, class AL, class EP>
__device__ __forceinline__ void gemm_tile(const AL& al, const bf16_t* __restrict__ Bt, int K, int row0, int col0, const EP& ep, char* smem) {
  constexpr int LDT = 72;
  bf16_t* sA0 = (bf16_t*)smem;
  bf16_t* sB0 = sA0 + 256 * LDT;
  bf16_t* sA1 = (bf16_t*)(smem + 55296);
  bf16_t* sB1 = sA1 + 256 * LDT;
  const int tid = tid_(), wave = tid >> 6, lane = tid & 63, wm = wave >> 1, wn = wave & 1, fr = lane & 15, fq = lane >> 4;
  const int lr = tid >> 3, lk = (tid & 7) * 8;
  f32x4 acc[4][4];
#pragma unroll
  for (int i = 0; i < 4; ++i)
#pragma unroll
    for (int j = 0; j < 4; ++j) acc[i][j] = (f32x4){0.f, 0.f, 0.f, 0.f};
  bf16x8 ra[4], rb[2];
  const int nk = K >> 6;
#pragma unroll
  for (int i = 0; i < 4; ++i) ra[i] = al(row0 + lr + 64 * i, lk);
#pragma unroll
  for (int i = 0; i < 2; ++i) rb[i] = *(const bf16x8*)(Bt + (size_t)(col0 + lr + 64 * i) * K + lk);
#pragma unroll
  for (int i = 0; i < 4; ++i) *(bf16x8*)(sA0 + (lr + 64 * i) * LDT + lk) = ra[i];
#pragma unroll
  for (int i = 0; i < 2; ++i) *(bf16x8*)(sB0 + (lr + 64 * i) * LDT + lk) = rb[i];
  __syncthreads();
  for (int kt = 0; kt < nk; ++kt) {
    const bool more = kt + 1 < nk;
    if (more) {
      const int k0 = (kt + 1) * 64 + lk;
#pragma unroll
      for (int i = 0; i < 4; ++i) ra[i] = al(row0 + lr + 64 * i, k0);
#pragma unroll
      for (int i = 0; i < 2; ++i) rb[i] = *(const bf16x8*)(Bt + (size_t)(col0 + lr + 64 * i) * K + k0);
    }
    const bf16_t* cA = (kt & 1) ? sA1 : sA0;
    const bf16_t* cB = (kt & 1) ? sB1 : sB0;
#pragma unroll
    for (int ks = 0; ks < 2; ++ks) {
      bf16x8 af[4], bfr[4];
#pragma unroll
      for (int mi = 0; mi < 4; ++mi) af[mi] = *(const bf16x8*)(cA + (wm * 64 + mi * 16 + fr) * LDT + ks * 32 + fq * 8);
#pragma unroll
      for (int ni = 0; ni < 4; ++ni) bfr[ni] = *(const bf16x8*)(cB + (wn * 64 + ni * 16 + fr) * LDT + ks * 32 + fq * 8);
#pragma unroll
      for (int mi = 0; mi < 4; ++mi)
#pragma unroll
        for (int ni = 0; ni < 4; ++ni) {
          if (TRANS) acc[mi][ni] = __builtin_amdgcn_mfma_f32_16x16x32_bf16(af[mi], bfr[ni], acc[mi][ni], 0, 0, 0);
          else acc[mi][ni] = __builtin_amdgcn_mfma_f32_16x16x32_bf16(bfr[ni], af[mi], acc[mi][ni], 0, 0, 0);
        }
    }
    if (more) {
      bf16_t* nA = (kt & 1) ? sA0 : sA1;
      bf16_t* nB = (kt & 1) ? sB0 : sB1;
#pragma unroll
      for (int i = 0; i < 4; ++i) *(bf16x8*)(nA + (lr + 64 * i) * LDT + lk) = ra[i];
#pragma unroll
      for (int i = 0; i < 2; ++i) *(bf16x8*)(nB + (lr + 64 * i) * LDT + lk) = rb[i];
    }
    __syncthreads();
  }
#pragma unroll
  for (int mi = 0; mi < 4; ++mi)
#pragma unroll
    for (int ni = 0; ni < 4; ++ni) {
      if (TRANS) ep(row0 + wm * 64 + mi * 16 + fq * 4, col0 + wn * 64 + ni * 16 + fr, acc[mi][ni]);
      else ep(row0 + wm * 64 + mi * 16 + fr, col0 + wn * 64 + ni * 16 + fq * 4, acc[mi][ni]);
    }
}

template <bool TRANS, class AL, class EP>
__device__ __forceinline__ void gemm_run_r(const AL& al, const bf16_t* Bt, int K, int M, int N, const EP& ep, char* smem, int rank, int nranks) {
  const int nM = M >> 8, nN = N >> 7, nt = nM * nN, nig = 8 * nN;
  for (int tile = rank; tile < nt; tile += nranks) {
    const int gid = tile / nig, fm = gid * 8, gsz = min(8, nM - fm);
    const int pm = fm + (tile % nig) % gsz, pn = (tile % nig) / gsz;
    gemm_tile<TRANS>(al, Bt, K, pm * 256, pn * 128, ep, smem);
  }
}
template <bool TRANS, class AL, class EP>
__device__ __forceinline__ int gemm_run(const AL& al, const bf16_t* Bt, int K, int M, int N, const EP& ep, char* smem, int gbase) {
  const int nM = M >> 8, nN = N >> 7, nt = nM * nN, G = gridDim.x;
  const int g0 = gbase + ((((int)blockIdx.x - gbase) % G) + G) % G;
  const int nig = 8 * nN;
  for (int g = g0; g < gbase + nt; g += G) {
    const int tile = g - gbase;
    const int gid = tile / nig, fm = gid * 8, gsz = min(8, nM - fm);
    const int pm = fm + (tile % nig) % gsz, pn = (tile % nig) / gsz;
    gemm_tile<TRANS>(al, Bt, K, pm * 256, pn * 128, ep, smem);
  }
  return gbase + nt;
}

struct EpTransBf16 {
  bf16_t* dst; size_t ld;
  __device__ __forceinline__ void operator()(int row, int col, f32x4 v) const {
    uint2 u; u.x = pack2(v[0], v[1]); u.y = pack2(v[2], v[3]);
    *(uint2*)(dst + (size_t)col * ld + row) = u;
  }
};
struct EpTransF32 {
  float* dst; size_t ld;
  __device__ __forceinline__ void operator()(int row, int col, f32x4 v) const { *(f32x4*)(dst + (size_t)col * ld + row) = v; }
};
struct EpBf16 {
  bf16_t* dst; size_t ld;
  __device__ __forceinline__ void operator()(int row, int col, f32x4 v) const {
    uint2 u; u.x = pack2(v[0], v[1]); u.y = pack2(v[2], v[3]);
    *(uint2*)(dst + (size_t)row * ld + col) = u;
  }
};
struct EpSqRelu {
  bf16_t* dst; size_t ld;
  __device__ __forceinline__ void operator()(int row, int col, f32x4 v) const {
    float a = fmaxf(v[0], 0.f), b = fmaxf(v[1], 0.f), c = fmaxf(v[2], 0.f), d = fmaxf(v[3], 0.f);
    uint2 u; u.x = pack2(a * a, b * b); u.y = pack2(c * c, d * d);
    *(uint2*)(dst + (size_t)row * ld + col) = u;
  }
};
struct EpResid {
  const float* src_lat; const float* src_ctx; float* dst_lat; float* dst_ctx; const float* modl; int chunk; int unperm;
  __device__ __forceinline__ void operator()(int row, int col, f32x4 v) const {
    const float* s; float* d; int which;
    if (row < MLAT) {
      int r = row; which = row >> 14;
      if (unperm) { int tp = row & (LSEQ - 1); r = (row & ~(LSEQ - 1)) + (tp & 255) * 64 + (tp >> 8); }
      s = src_lat + (size_t)r * 2048 + col; d = dst_lat + (size_t)r * 2048 + col;
    } else { which = 2; s = src_ctx + (size_t)(row - MLAT) * 2048 + col; d = dst_ctx + (size_t)(row - MLAT) * 2048 + col; }
    f32x4 g = *(const f32x4*)(modl + which * 12288 + chunk * 2048 + col);
    f32x4 x = *(const f32x4*)s;
    *(f32x4*)d = x + g * v;
  }
};
struct EpIn1 {
  bf16_t* dst; const float* hg_lb;
  __device__ __forceinline__ void operator()(int row, int col, f32x4 v) const {
    float o[4];
    if (col < 1024 || (col >= 4096 && col < 5120)) {
#pragma unroll
      for (int j = 0; j < 4; ++j) o[j] = siluf_(v[j]);
    } else if (col < 3072) {
#pragma unroll
      for (int j = 0; j < 4; ++j) {
        int i = col - 1024 + j;
        float lb = 1.f / (1.f + expf(hg_lb[i] - hg_lb[2048 + i]));
        o[j] = (1.f - lb) / (1.f + expf(v[j]));
      }
    } else if (col >= 6144) {
#pragma unroll
      for (int j = 0; j < 4; ++j) o[j] = gelu_tanh_(v[j]);
    } else {
#pragma unroll
      for (int j = 0; j < 4; ++j) o[j] = v[j];
    }
    uint2 u; u.x = pack2(o[0], o[1]); u.y = pack2(o[2], o[3]);
    *(uint2*)(dst + (size_t)row * 7168 + col) = u;
  }
};

namespace pg8 {
#define PG8_LAS __attribute__((address_space(3)))
typedef unsigned short bf16_t;
typedef short bf16x8 __attribute__((ext_vector_type(8)));
typedef float f32x4 __attribute__((ext_vector_type(4)));
typedef unsigned u32x4 __attribute__((ext_vector_type(4)));
constexpr int BM = 256, BK = 64, HALF = 128, HTB = HALF * BK * 2  , STAGE_BYTES = 8 * HTB, NXCD = 8, WGM = 8;

__host__ __device__ __forceinline__ int lds_byte(int r, int c) { const int st = (r >> 4) * 2 + (c >> 5), rr = r & 15, cc = c & 31, ob = rr * 64 + cc * 2; return st * 1024 + (ob ^ (((ob >> 9) & 1) << 5)); }
__host__ __device__ __forceinline__ void stage_rc(int b, int& R, int& C) { const int st = b / 1024, sb = b % 1024, swz = sb ^ (((sb >> 9) & 1) << 5); R = (st >> 1) * 16 + swz / 64; C = (st & 1) * 32 + (swz % 64) / 2; }
__host__ __device__ __forceinline__ int perm32(int rho) { const int n = rho >> 4, i = rho & 15; return 8 * (i >> 2) + 4 * n + (i & 3); }

struct Unit { int pm, pn; };
struct Gemm { const bf16_t* A; const bf16_t* Bt; int M, N, K, ld; };

struct StaticOrder {
    int nM, nN, nwg, G, c;
    __host__ __device__ void init(int M, int N, int G_, int c_) { nM = M / BM; nN = N / BM; nwg = nM * nN; G = G_; c = c_; }
    __host__ __device__ bool next(int i, Unit& u) const {
        const long L = (long)i * G + c; if (L >= nwg) return false;
        int wgid = (int)L; { const int q = nwg / NXCD, r = nwg % NXCD, xcd = wgid % NXCD, off = wgid / NXCD; wgid = (xcd < r ? xcd * (q + 1) : r * (q + 1) + (xcd - r) * q) + off; }
        const int nig = WGM * nN, gid = wgid / nig, fm = gid * WGM, gsz = (nM - fm) < WGM ? (nM - fm) : WGM;
        u.pm = fm + ((wgid % nig) % gsz); u.pn = (wgid % nig) / gsz; return true;
    }
    __device__ __forceinline__ void a_ready(const Unit&) const {}
    __device__ __forceinline__ void done(const Unit&) const {}
};
__device__ __forceinline__ unsigned cvt_pk_bf16(float lo, float hi) { unsigned r; asm volatile("v_cvt_pk_bf16_f32 %0, %1, %2" : "=v"(r) : "v"(lo), "v"(hi)); return r; }
template <class Epi, class Sched, bool STAMP = false>
__device__ __forceinline__ void gemm_phase(PG8_LAS unsigned char* lds, const Gemm g, const Sched& S, const Epi& E, unsigned long long* stamps) {
    const int tid = threadIdx.x, wid = __builtin_amdgcn_readfirstlane(tid >> 6), lane = tid & 63, wr = wid >> 2, wc = wid & 3, fr = lane & 15, fq = lane >> 4;
    const int K = g.ld, nt = g.K / BK;
    int ts_lo = 0, ts_hi = 0, nts = 0; const unsigned long long rt_entry = STAMP ? (unsigned long long)wall_clock64() : 0ull;
#define PG8_STAMP() do { if (STAMP && wid == 0 && nts < 64) { const unsigned long long _c = (unsigned long long)clock64(); \
        ts_lo = (lane == nts) ? (int)(unsigned)_c : ts_lo; ts_hi = (lane == nts) ? (int)(unsigned)(_c >> 32) : ts_hi; ++nts; } } while (0)
    PG8_STAMP();
    unsigned voffA[2], voffB[2];
#pragma unroll
    for (int i = 0; i < 2; ++i) { int R, C; stage_rc(tid * 16 + i * 8192, R, C); const int Rb = Epi::PERM ? ((R & ~31) + perm32(R & 31)) : R;
        voffA[i] = (unsigned)(R * K + C) * 2u; voffB[i] = (unsigned)(Rb * K + C) * 2u; }
    const size_t kstep = (size_t)(BK * 2);
    const size_t hstep = (size_t)HALF * K * 2;
    const size_t tstep = 2 * hstep;
    const unsigned ldsw = (unsigned)wid * 1024u;
    const int aoff = lds_byte(wr * 64 + fr, fq * 8), boff = lds_byte(wc * 32 + fr, fq * 8);
#define PG8_SA(b, h) (((b) * 2 + (h)) * HTB)
#define PG8_SB(b, h) ((4 + (b) * 2 + (h)) * HTB)
#define PG8_STAGE(bufoff, gbase, voff) do { _Pragma("unroll") for (int _i = 0; _i < 2; ++_i) \
        __builtin_amdgcn_global_load_lds((const unsigned*)((const char*)(gbase) + (voff)[_i]), (PG8_LAS unsigned*)(lds + (bufoff) + ldsw + _i * 8192), 16, 0, 0); } while (0)
#define PG8_LDA(dst, b, h) do { _Pragma("unroll") for (int m = 0; m < 4; ++m) _Pragma("unroll") for (int k = 0; k < 2; ++k) dst[m][k] = *(const PG8_LAS bf16x8*)(lds + PG8_SA(b, h) + aoff + m * 2048 + k * 1024); } while (0)
#define PG8_LDB(dst, b, h) do { _Pragma("unroll") for (int n = 0; n < 2; ++n) _Pragma("unroll") for (int k = 0; k < 2; ++k) dst[n][k] = *(const PG8_LAS bf16x8*)(lds + PG8_SB(b, h) + boff + n * 2048 + k * 1024); } while (0)
#define PG8_MMA(ai, bj, At, Bt) do { __builtin_amdgcn_s_setprio(1); _Pragma("unroll") for (int m = 0; m < 4; ++m) _Pragma("unroll") for (int n = 0; n < 2; ++n) _Pragma("unroll") for (int k = 0; k < 2; ++k) \
        acc[ai][bj][m][n] = __builtin_amdgcn_mfma_f32_16x16x32_bf16(Bt[n][k], At[m][k], acc[ai][bj][m][n], 0, 0, 0); __builtin_amdgcn_s_setprio(0); } while (0)
#define PG8_WAIT_V(n) asm volatile("s_waitcnt vmcnt(" #n ")" ::: "memory")
#define PG8_WAIT_L(n) asm volatile("s_waitcnt lgkmcnt(" #n ")" ::: "memory")
#define PG8_BAR __builtin_amdgcn_s_barrier()
#define PG8_SCHED __builtin_amdgcn_sched_barrier(0)
    Unit cur, nxt; int ui = 0;
    if (!S.next(0, cur)) return;
    f32x4 acc[2][2][4][2];
#pragma unroll
    for (int a = 0; a < 2; ++a)
#pragma unroll
        for (int b = 0; b < 2; ++b)
#pragma unroll
            for (int m = 0; m < 4; ++m)
#pragma unroll
                for (int n = 0; n < 2; ++n) acc[a][b][m][n] = (f32x4){0.f, 0.f, 0.f, 0.f};
    bf16x8 At[4][2], B0[2][2], B1[2][2];
    const char* cA = (const char*)g.A + (size_t)cur.pm * tstep; const char* cB = (const char*)g.Bt + (size_t)cur.pn * tstep;
    S.a_ready(cur);
    PG8_STAGE(PG8_SB(0, 0), cB, voffB); PG8_STAGE(PG8_SA(0, 0), cA, voffA); PG8_STAGE(PG8_SB(0, 1), cB + hstep, voffB); PG8_STAGE(PG8_SA(0, 1), cA + hstep, voffA);
    if (wr == 1) PG8_BAR;
    PG8_WAIT_V(4); PG8_BAR;
    PG8_STAGE(PG8_SB(1, 0), cB + kstep, voffB); PG8_STAGE(PG8_SA(1, 0), cA + kstep, voffA); PG8_STAGE(PG8_SB(1, 1), cB + hstep + kstep, voffB);
    PG8_WAIT_V(6); PG8_BAR;
    PG8_STAMP();
    for (;;) {
        const bool has_next = S.next(ui + 1, nxt);
        const char* nA = has_next ? (const char*)g.A + (size_t)nxt.pm * tstep : cA; const char* nB = has_next ? (const char*)g.Bt + (size_t)nxt.pn * tstep : cB;
        for (int t = 0; t < nt; t += 2) {
            const bool last = (t == nt - 2);
            const char* a1 = cA + (size_t)(t + 1) * kstep;
            const char* a2 = last ? nA : cA + (size_t)(t + 2) * kstep; const char* b2 = last ? nB : cB + (size_t)(t + 2) * kstep;
            const char* a3 = a2 + kstep; const char* b3 = b2 + kstep;
            if (last && has_next) S.a_ready(nxt);
            PG8_LDB(B0, 0, 0); PG8_SCHED; PG8_LDA(At, 0, 0); PG8_STAGE(PG8_SA(1, 1), a1 + hstep, voffA);
            PG8_WAIT_L(8); PG8_BAR; PG8_WAIT_L(0); PG8_MMA(0, 0, At, B0); PG8_BAR; PG8_SCHED;
            PG8_LDB(B1, 0, 1); PG8_STAGE(PG8_SB(0, 0), b2, voffB);
            PG8_BAR; PG8_WAIT_L(0); PG8_MMA(0, 1, At, B1); PG8_BAR;
            PG8_LDA(At, 0, 1); PG8_STAGE(PG8_SA(0, 0), a2, voffA);
            PG8_BAR; PG8_WAIT_L(0); PG8_MMA(1, 0, At, B0); PG8_BAR; PG8_SCHED;
            PG8_STAGE(PG8_SB(0, 1), b2 + hstep, voffB);
            PG8_WAIT_V(6); PG8_BAR; PG8_MMA(1, 1, At, B1); PG8_BAR;
            PG8_LDB(B0, 1, 0); PG8_SCHED; PG8_LDA(At, 1, 0); PG8_STAGE(PG8_SA(0, 1), a2 + hstep, voffA);
            PG8_WAIT_L(8); PG8_BAR; PG8_WAIT_L(0); PG8_MMA(0, 0, At, B0); PG8_BAR; PG8_SCHED;
            PG8_LDB(B1, 1, 1); PG8_STAGE(PG8_SB(1, 0), b3, voffB);
            PG8_BAR; PG8_WAIT_L(0); PG8_MMA(0, 1, At, B1); PG8_BAR;
            PG8_LDA(At, 1, 1); PG8_STAGE(PG8_SA(1, 0), a3, voffA);
            PG8_BAR; PG8_WAIT_L(0); PG8_MMA(1, 0, At, B0); PG8_BAR; PG8_SCHED;
            PG8_STAGE(PG8_SB(1, 1), b3 + hstep, voffB);
            PG8_WAIT_V(6); PG8_BAR; PG8_MMA(1, 1, At, B1); PG8_BAR;
        }
        PG8_STAMP();
        if constexpr (!Epi::AFTER_DRAIN) { E(acc, cur, wr, wc, fr, fq); S.done(cur); }
        PG8_STAMP();
        if (!has_next) break;
#pragma unroll
        for (int a = 0; a < 2; ++a)
#pragma unroll
            for (int b = 0; b < 2; ++b)
#pragma unroll
                for (int m = 0; m < 4; ++m)
#pragma unroll
                    for (int n = 0; n < 2; ++n) acc[a][b][m][n] = (f32x4){0.f, 0.f, 0.f, 0.f};
        cur = nxt; cA = nA; cB = nB; ++ui;
    }
    PG8_WAIT_V(0);
    if (wr == 0) PG8_BAR;
    PG8_BAR;
    if constexpr (Epi::AFTER_DRAIN) { E.fused(acc, cur, wr, wc, fr, fq, lds, wid, lane); S.done(cur); }
    PG8_STAMP();
    if (STAMP && wid == 0) { stamps[lane] = lane < nts ? (((unsigned long long)(unsigned)ts_hi << 32) | (unsigned)ts_lo) : 0ull;
        if (lane == 62) stamps[62] = rt_entry; if (lane == 63) stamps[63] = (unsigned long long)wall_clock64(); }
#undef PG8_STAMP
#undef PG8_SA
#undef PG8_SB
#undef PG8_STAGE
#undef PG8_LDA
#undef PG8_LDB
#undef PG8_MMA
#undef PG8_WAIT_V
#undef PG8_WAIT_L
#undef PG8_BAR
#undef PG8_SCHED
}
}

struct ActNone { __device__ __forceinline__ void operator()(int, f32x4&, f32x4&) const {} };
struct ActSqRelu { __device__ __forceinline__ void operator()(int, f32x4& a, f32x4& b) const {
#pragma unroll
  for (int j = 0; j < 4; ++j) { float x = fmaxf(a[j], 0.f), y = fmaxf(b[j], 0.f); a[j] = x * x; b[j] = y * y; } } };
struct ActIn1 { const float* hg_lb;
  __device__ __forceinline__ void operator()(int col, f32x4& a, f32x4& b) const {
    if (col < 1024 || (col >= 4096 && col < 5120)) {
#pragma unroll
      for (int j = 0; j < 4; ++j) { a[j] = a[j] * fsig(a[j]); b[j] = b[j] * fsig(b[j]); }
    } else if (col < 3072) {
#pragma unroll
      for (int j = 0; j < 4; ++j) {
        int i = col - 1024 + j;
        float lb0 = fsig(hg_lb[2048 + i] - hg_lb[i]), lb1 = fsig(hg_lb[2048 + i + 4] - hg_lb[i + 4]);
        a[j] = (1.f - lb0) * fsig(-a[j]); b[j] = (1.f - lb1) * fsig(-b[j]);
      }
    } else if (col >= 6144) {
#pragma unroll
      for (int j = 0; j < 4; ++j) {
        float ua = 1.5957691216f * (a[j] + 0.044715f * a[j] * a[j] * a[j]), ub = 1.5957691216f * (b[j] + 0.044715f * b[j] * b[j] * b[j]);
        a[j] = a[j] * fsig(ua); b[j] = b[j] * fsig(ub);
      }
    }
  } };
template <class ACT> struct PEpiBf16 {
  static constexpr bool PERM = true, AFTER_DRAIN = false;
  bf16_t* O; size_t ldc; int ncols; ACT act;
  __device__ __forceinline__ void operator()(const f32x4 (&acc)[2][2][4][2], const pg8::Unit& u, int wr, int wc, int fr, int fq) const {
    const int row0 = u.pm * 256 + wr * 64 + fr, col0 = u.pn * 256 + wc * 32 + 8 * fq;
#pragma unroll
    for (int ai = 0; ai < 2; ++ai)
#pragma unroll
      for (int m = 0; m < 4; ++m) {
        bf16_t* rowp = O + (size_t)(row0 + ai * 128 + m * 16) * ldc + col0;
#pragma unroll
        for (int bj = 0; bj < 2; ++bj) {
          const int c = col0 + bj * 128;
          if (c < ncols) {
            f32x4 v0 = acc[ai][bj][m][0], v1 = acc[ai][bj][m][1];
            act(c, v0, v1);
            pg8::u32x4 w; w.x = pack2(v0[0], v0[1]); w.y = pack2(v0[2], v0[3]); w.z = pack2(v1[0], v1[1]); w.w = pack2(v1[2], v1[3]);
            *(pg8::u32x4*)(rowp + bj * 128) = w;
          }
        }
      }
  }
};
struct PEpiResid {
  static constexpr bool PERM = false, AFTER_DRAIN = false;
  const float* src_lat; const float* src_ctx; float* dst_lat; float* dst_ctx; const float* modl; int chunk; int unperm;
  __device__ __forceinline__ void operator()(const f32x4 (&acc)[2][2][4][2], const pg8::Unit& u, int wr, int wc, int fr, int fq) const {
    const int row0 = u.pm * 256 + wr * 64 + fr, col0 = u.pn * 256 + wc * 32 + 4 * fq;
#pragma unroll
    for (int ai = 0; ai < 2; ++ai)
#pragma unroll
      for (int m = 0; m < 4; ++m) {
        const int row = row0 + ai * 128 + m * 16;
        const float* s; float* d; int which;
        if (row < MLAT) {
          int r = row; which = row >> 14;
          if (unperm) { int tp = row & (LSEQ - 1); r = (row & ~(LSEQ - 1)) + (tp & 255) * 64 + (tp >> 8); }
          s = src_lat + (size_t)r * 2048; d = dst_lat + (size_t)r * 2048;
        } else { which = 2; s = src_ctx + (size_t)(row - MLAT) * 2048; d = dst_ctx + (size_t)(row - MLAT) * 2048; }
        const float* gp = modl + which * 12288 + chunk * 2048;
#pragma unroll
        for (int bj = 0; bj < 2; ++bj)
#pragma unroll
          for (int n = 0; n < 2; ++n) {
            const int col = col0 + bj * 128 + n * 16;
            f32x4 g = *(const f32x4*)(gp + col), x = *(const f32x4*)(s + col);
            *(f32x4*)(d + col) = x + g * acc[ai][bj][m][n];
          }
      }
  }
};
template <class Epi>
__device__ __forceinline__ int pg8_run(char* smem, const bf16_t* A, const bf16_t* Bt, int M, int N, int K, const Epi& E, int rot) {
  pg8::StaticOrder S; S.init(M, N, (int)gridDim.x, (int)((blockIdx.x + gridDim.x - rot) % gridDim.x));
  pg8::gemm_phase<Epi, pg8::StaticOrder, false>((PG8_LAS unsigned char*)smem, pg8::Gemm{A, Bt, M, N, K, K}, S, E, nullptr);
  return (rot + (M / 256) * (N / 256)) % (int)gridDim.x;
}


struct PEpiPartial {
  static constexpr bool PERM = false, AFTER_DRAIN = false;
  float* part;
  __device__ __forceinline__ void operator()(const f32x4 (&acc)[2][2][4][2], const pg8::Unit& u, int wr, int wc, int fr, int fq) const {
    const int row0 = u.pm * 256 + wr * 64 + fr, col0 = u.pn * 256 + wc * 32 + 4 * fq;
#pragma unroll
    for (int ai = 0; ai < 2; ++ai)
#pragma unroll
      for (int m = 0; m < 4; ++m) {
        float* d = part + (size_t)(row0 + ai * 128 + m * 16) * 2048 + col0;
#pragma unroll
        for (int bj = 0; bj < 2; ++bj)
#pragma unroll
          for (int n = 0; n < 2; ++n) *(f32x4*)(d + bj * 128 + n * 16) = acc[ai][bj][m][n];
      }
  }
};
__device__ __forceinline__ void pg8_ctx_splitk(char* smem, const bf16_t* A, const bf16_t* Bt, int K, float* part, int rot0) {
  const int Ks = K / 8, G = (int)gridDim.x;
#pragma unroll 1
  for (int ks = 0; ks < 8; ++ks) {
    pg8::StaticOrder S; S.init(512, 2048, G, (int)(((int)blockIdx.x + 64 * G - rot0 - 16 * ks) % G));
    pg8::gemm_phase<PEpiPartial, pg8::StaticOrder, false>((PG8_LAS unsigned char*)smem, pg8::Gemm{A + ks * Ks, Bt + ks * Ks, 512, 2048, Ks, K}, S, PEpiPartial{part + (size_t)ks * 512 * 2048}, nullptr);
  }
}

__device__ __forceinline__ void adaln_task(const Params& P, char* smem, int task) {
  float* s = (float*)smem;
  float* red = s + 3 * 2048;
  const int tid = tid_(), l = task / 96, cgp = task % 96;
  for (int i = tid; i < 3 * 2048; i += NT) {
    int w = i >> 11, k = i & 2047;
    float v = (w < 2) ? P.c[w * 2048 + k] : P.c_ctx[k];
    s[i] = siluf_(v);
  }
  __syncthreads();
  const int c4 = tid & 31, ks = tid >> 5;
  const float* W = P.ada_w + (size_t)l * 2048 * 12288 + cgp * 128 + c4 * 4;
  float a0[4] = {0, 0, 0, 0}, a1[4] = {0, 0, 0, 0}, a2[4] = {0, 0, 0, 0};
  for (int k = ks * 128; k < ks * 128 + 128; ++k) {
    float4 w = *(const float4*)(W + (size_t)k * 12288);
    float s0 = s[k], s1 = s[2048 + k], s2 = s[4096 + k];
    a0[0] += s0 * w.x; a0[1] += s0 * w.y; a0[2] += s0 * w.z; a0[3] += s0 * w.w;
    a1[0] += s1 * w.x; a1[1] += s1 * w.y; a1[2] += s1 * w.z; a1[3] += s1 * w.w;
    a2[0] += s2 * w.x; a2[1] += s2 * w.y; a2[2] += s2 * w.z; a2[3] += s2 * w.w;
  }
#pragma unroll
  for (int j = 0; j < 4; ++j) {
    red[(ks * 3 + 0) * 128 + c4 * 4 + j] = a0[j];
    red[(ks * 3 + 1) * 128 + c4 * 4 + j] = a1[j];
    red[(ks * 3 + 2) * 128 + c4 * 4 + j] = a2[j];
  }
  __syncthreads();
  if (tid < 384) {
    int w = tid >> 7, cc = tid & 127;
    float sum = 0.f;
    for (int k = 0; k < 16; ++k) sum += red[(k * 3 + w) * 128 + cc];
    int col = cgp * 128 + cc;
    P.mod[(size_t)(l * 3 + w) * 12288 + col] = sum + P.ada_b[l * 12288 + col];
  }
  __syncthreads();
}

__device__ __forceinline__ void cvt_tile(const float* __restrict__ src, int K, int N, bf16_t* __restrict__ dst, int tile, char* smem) {
  float* t = (float*)smem;
  const int tid = tid_(), nT = N >> 7, kt = tile / nT, nt = tile % nT;
  float4 v[4];
#pragma unroll
  for (int i = 0; i < 4; ++i) {
    int r = (tid >> 5) + 16 * i, c4 = (tid & 31) * 4;
    v[i] = *(const float4*)(src + (size_t)(kt * 64 + r) * N + nt * 128 + c4);
  }
#pragma unroll
  for (int i = 0; i < 4; ++i) {
    int r = (tid >> 5) + 16 * i, c4 = (tid & 31) * 4;
    t[r * 129 + c4] = v[i].x; t[r * 129 + c4 + 1] = v[i].y; t[r * 129 + c4 + 2] = v[i].z; t[r * 129 + c4 + 3] = v[i].w;
  }
  __syncthreads();
#pragma unroll
  for (int i = 0; i < 2; ++i) {
    int n = (tid >> 3) + 64 * i, k8 = (tid & 7) * 8;
    bf16x8 o;
#pragma unroll
    for (int j = 0; j < 8; ++j) o[j] = (short)f2bf(t[(k8 + j) * 129 + n]);
    *(bf16x8*)(dst + (size_t)(nt * 128 + n) * K + kt * 64 + k8) = o;
  }
  __syncthreads();
}
__device__ __forceinline__ int cvt_run_r(const float* src, int K, int N, bf16_t* dst, char* smem, int gbase, int rank, int nranks) {
  const int nt = (K >> 6) * (N >> 7);
  const int g0 = gbase + (((rank - gbase) % nranks) + nranks) % nranks;
  for (int g = g0; g < gbase + nt; g += nranks) cvt_tile(src, K, N, dst, g - gbase, smem);
  return gbase + nt;
}
__device__ __forceinline__ int cvt_run(const float* src, int K, int N, bf16_t* dst, char* smem, int gbase) {
  const int nt = (K >> 6) * (N >> 7), G = gridDim.x;
  const int g0 = gbase + ((((int)blockIdx.x - gbase) % G) + G) % G;
  for (int g = g0; g < gbase + nt; g += G) cvt_tile(src, K, N, dst, g - gbase, smem);
  return gbase + nt;
}

__device__ __forceinline__ void hyena_h2_phase(const Params& P, char* smem) {
  float* zs = (float*)smem;
  float* h1s = zs + 8 * 64;
  float* w1s = h1s + 8 * 64;
  float* w2s = w1s + 33 * 64;
  const int tid = tid_(), wave = tid >> 6, lane = tid & 63;
  __syncthreads();
  for (int i = tid; i < 33 * 64; i += NT) w1s[i] = P.hy_f_w1[i];
  for (int i = tid; i < 64 * 64; i += NT) w2s[i] = P.hy_f_w2[i];
  const float fq0 = P.hy_freq[lane], fq1 = P.hy_freq[64 + lane], b1 = P.hy_f_b1[lane], b2 = P.hy_f_b2[lane];
  __syncthreads();
  for (int base = blockIdx.x * 8; base < 16640; base += gridDim.x * 8) {
    const int idx = base + wave;
    const int L = idx < LSEQ ? LSEQ : 256, n = idx < LSEQ ? idx : idx - LSEQ;
    float zv = 0.f;
    if (lane == 0) zv = (float)n / (float)(L - 1);
    else if (lane < 33) {
      int i = (lane - 1) & 15;
      float fr = 1e-4f + (float)i * ((15.f - 1e-4f) / 15.f);
      float w = (6.283185307179586f * (float)n) / (float)L;
      float a = fr * w;
      zv = lane < 17 ? cosf(a) : -sinf(a);
    }
    zs[wave * 64 + lane] = zv;
    __syncthreads();
    float acc = b1;
#pragma unroll 11
    for (int i = 0; i < 33; ++i) acc += zs[wave * 64 + i] * w1s[i * 64 + lane];
    h1s[wave * 64 + lane] = sinf(fq0 * acc);
    __syncthreads();
    float acc2 = b2;
#pragma unroll 16
    for (int i = 0; i < 64; ++i) acc2 += h1s[wave * 64 + i] * w2s[i * 64 + lane];
    float h2 = sinf(fq1 * acc2);
    if (idx < LSEQ) P.h2b[(size_t)n * 64 + lane] = f2bf(h2); else P.h2cb[(size_t)n * 64 + lane] = f2bf(h2);
    __syncthreads();
  }
}

__device__ __forceinline__ void norm_phase(const float* xlat, const float* xctx, const float* nw, const float* modl, int chunk_shift, bf16_t* H, int nrows, int perm,
                                           const float* part = nullptr, const float* gate_ctx = nullptr, float* xc_out = nullptr) {
  const int tid = tid_(), wave = tid >> 6, lane = tid & 63;
  for (int row = blockIdx.x * 8 + wave; row < nrows; row += gridDim.x * 8) {
    const float* src = row < MLAT ? xlat + (size_t)row * 2048 : xctx + (size_t)(row - MLAT) * 2048;
    const int which = row < MLAT ? (row >> 14) : 2;
    float4 v[8]; float ss = 0.f;
#pragma unroll
    for (int i = 0; i < 8; ++i) v[i] = *(const float4*)(src + (i * 64 + lane) * 4);
    if (part != nullptr && row >= MLAT) {
#pragma unroll
      for (int i = 0; i < 8; ++i) {
        const int col = (i * 64 + lane) * 4;
        float4 a = make_float4(0.f, 0.f, 0.f, 0.f);
#pragma unroll
        for (int ks = 0; ks < 8; ++ks) { const float4 pq = *(const float4*)(part + ((size_t)ks * 512 + (row - MLAT)) * 2048 + col); a.x += pq.x; a.y += pq.y; a.z += pq.z; a.w += pq.w; }
        const float4 g = *(const float4*)(gate_ctx + col);
        v[i].x += g.x * a.x; v[i].y += g.y * a.y; v[i].z += g.z * a.z; v[i].w += g.w * a.w;
        *(float4*)(xc_out + (size_t)(row - MLAT) * 2048 + col) = v[i];
      }
    }
#pragma unroll
    for (int i = 0; i < 8; ++i) ss += v[i].x * v[i].x + v[i].y * v[i].y + v[i].z * v[i].z + v[i].w * v[i].w;
    ss = wave_sum(ss);
    const float rs = rsqrtf(ss * (1.f / 2048.f) + 1e-6f);
    int drow = row;
    if (perm && row < MLAT) { int t = row & (LSEQ - 1); drow = (row & ~(LSEQ - 1)) + (t & 63) * 256 + (t >> 6); }
    const float* sh = modl + which * 12288 + chunk_shift * 2048;
    const float* sc = sh + 2048;
#pragma unroll
    for (int i = 0; i < 8; ++i) {
      int col = (i * 64 + lane) * 4;
      float4 w = *(const float4*)(nw + col), s1 = *(const float4*)(sc + col), s0 = *(const float4*)(sh + col);
      float o0 = v[i].x * rs * w.x * (1.f + s1.x) + s0.x, o1 = v[i].y * rs * w.y * (1.f + s1.y) + s0.y;
      float o2 = v[i].z * rs * w.z * (1.f + s1.z) + s0.z, o3 = v[i].w * rs * w.w * (1.f + s1.w) + s0.w;
      uint2 u; u.x = pack2(o0, o1); u.y = pack2(o2, o3);
      *(uint2*)(H + (size_t)drow * 2048 + col) = u;
    }
  }
}

__device__ __forceinline__ void final_norm_phase(float* xl, const float* w) {
  const int tid = tid_(), wave = tid >> 6, lane = tid & 63;
  for (int row = blockIdx.x * 8 + wave; row < MLAT; row += gridDim.x * 8) {
    float* src = xl + (size_t)row * 2048;
    float4 v[8]; float ss = 0.f;
#pragma unroll
    for (int i = 0; i < 8; ++i) {
      v[i] = *(const float4*)(src + (i * 64 + lane) * 4);
      ss += v[i].x * v[i].x + v[i].y * v[i].y + v[i].z * v[i].z + v[i].w * v[i].w;
    }
    ss = wave_sum(ss);
    const float rs = rsqrtf(ss * (1.f / 2048.f) + 1e-6f);
#pragma unroll
    for (int i = 0; i < 8; ++i) {
      int col = (i * 64 + lane) * 4;
      float4 ww = *(const float4*)(w + col);
      float4 o = make_float4(v[i].x * rs * ww.x, v[i].y * rs * ww.y, v[i].z * rs * ww.z, v[i].w * rs * ww.w);
      *(float4*)(src + col) = o;
    }
  }
}

__device__ __forceinline__ int swz(int i) { return i ^ (((i >> 5) & 1) * 5) ^ (((i >> 6) & 1) * 26); }
__device__ __forceinline__ void fft_twid(const float2* TW, int kt, float2& w1, float2& w2, float2& w3) {
  w1 = cmul(TW[kt >> 7], TW[128 + (kt & 127)]); w2 = cmul(w1, w1); w3 = cmul(w2, w1);
}
__device__ __forceinline__ void fft_fwd(float2* X, const float2* TW) {
  const int tid = tid_();
#pragma unroll 1
  for (int lq = 12; lq >= 0; lq -= 2) {
    const int q = 1 << lq, tws = 4096 >> lq;
    const bool big = lq >= 10;
    float2 w1, w2, w3;
    if (!big) fft_twid(TW, (tid & (q - 1)) * tws, w1, w2, w3);
#pragma unroll 4
    for (int i = 0; i < 8; ++i) {
      const int bidx = tid + NT * i, j = bidx & (q - 1), base = ((bidx >> lq) << (lq + 2)) + j;
      int i0, i1, i2, i3;
      if (big) { i0 = swz(base); i1 = i0 + q; i2 = i1 + q; i3 = i2 + q; fft_twid(TW, j * tws, w1, w2, w3); }
      else { i0 = swz(base); i1 = swz(base + q); i2 = swz(base + 2 * q); i3 = swz(base + 3 * q); }
      float2 a0 = X[i0], a1 = X[i1], a2 = X[i2], a3 = X[i3];
      float2 t0 = make_float2(a0.x + a2.x, a0.y + a2.y), t1 = make_float2(a0.x - a2.x, a0.y - a2.y);
      float2 t2 = make_float2(a1.x + a3.x, a1.y + a3.y), d = make_float2(a1.x - a3.x, a1.y - a3.y);
      float2 t3 = make_float2(d.y, -d.x);
      float2 y0 = make_float2(t0.x + t2.x, t0.y + t2.y), y1 = make_float2(t1.x + t3.x, t1.y + t3.y);
      float2 y2 = make_float2(t0.x - t2.x, t0.y - t2.y), y3 = make_float2(t1.x - t3.x, t1.y - t3.y);
      X[i0] = y0; X[i1] = cmul(y1, w1); X[i2] = cmul(y2, w2); X[i3] = cmul(y3, w3);
    }
    __syncthreads();
  }
}
__device__ __forceinline__ void fft_inv(float2* X, const float2* TW) {
  const int tid = tid_();
#pragma unroll 1
  for (int lq = 0; lq <= 12; lq += 2) {
    const int q = 1 << lq, tws = 4096 >> lq;
    const bool big = lq >= 10;
    float2 w1, w2, w3;
    if (!big) fft_twid(TW, (tid & (q - 1)) * tws, w1, w2, w3);
#pragma unroll 4
    for (int i = 0; i < 8; ++i) {
      const int bidx = tid + NT * i, j = bidx & (q - 1), base = ((bidx >> lq) << (lq + 2)) + j;
      int i0, i1, i2, i3;
      if (big) { i0 = swz(base); i1 = i0 + q; i2 = i1 + q; i3 = i2 + q; fft_twid(TW, j * tws, w1, w2, w3); }
      else { i0 = swz(base); i1 = swz(base + q); i2 = swz(base + 2 * q); i3 = swz(base + 3 * q); }
      float2 b0 = X[i0], b1 = cmulc(X[i1], w1), b2 = cmulc(X[i2], w2), b3 = cmulc(X[i3], w3);
      float2 t0 = make_float2(b0.x + b2.x, b0.y + b2.y), t1 = make_float2(b0.x - b2.x, b0.y - b2.y);
      float2 t2 = make_float2(b1.x + b3.x, b1.y + b3.y), d = make_float2(b1.x - b3.x, b1.y - b3.y);
      float2 t3 = make_float2(-d.y, d.x);
      X[i0] = make_float2(t0.x + t2.x, t0.y + t2.y); X[i1] = make_float2(t1.x + t3.x, t1.y + t3.y);
      X[i2] = make_float2(t0.x - t2.x, t0.y - t2.y); X[i3] = make_float2(t1.x - t3.x, t1.y - t3.y);
    }
    __syncthreads();
  }
}

__device__ __forceinline__ float conv3_at(const bf16_t* __restrict__ col, int n, int len, float w0, float w1, float w2, float bb) {
  float c = bf2f(col[n]);
  float p = n > 0 ? bf2f(col[n - 1]) : 0.f;
  float x = n < len - 1 ? bf2f(col[n + 1]) : 0.f;
  return bb + w0 * p + w1 * c + w2 * x;
}

__device__ __forceinline__ void hyena_channel(const Params& P, int c, char* smem) {
  float2* X = (float2*)smem;
  float* red = (float*)(smem + 131072);
  const int tid = tid_();
  const float2* TW = (const float2*)(smem + 131072 + 1024);
  const float2* __restrict__ HF = P.half;
  const bf16_t* pv = P.RP + (size_t)c * MALL;
  const bf16_t* px1 = P.RP + (size_t)(1024 + c) * MALL;
  const bf16_t* px2 = P.RP + (size_t)(2048 + c) * MALL;
  const float* cw = P.hy_conv_w; const float* cb = P.hy_conv_b;
  const float vw0 = cw[c], vw1 = cw[3072 + c], vw2 = cw[6144 + c], vb = cb[c];
  const float aw0 = cw[1024 + c], aw1 = cw[3072 + 1024 + c], aw2 = cw[6144 + 1024 + c], ab = cb[1024 + c];
  const float bw0 = cw[2048 + c], bw1 = cw[3072 + 2048 + c], bw2 = cw[6144 + 2048 + c], bb = cb[2048 + c];
  const float dlo = -3.0701134573253944f, dhi = -15.350567286626972f;
  const float delta = fabsf(dlo + (dhi - dlo) * ((float)c / 1023.f));
  const float* taps = P.out;
  float2 K[32];
  float2* __restrict__ Rg = (float2*)(P.RA + (size_t)3 * MALL * 1024) + (size_t)blockIdx.x * (2 * LSEQ);
  float2* __restrict__ Zg = Rg + LSEQ;
#pragma unroll 8
  for (int i = 0; i < 32; ++i) {
    const int n = tid + NT * i;
    Zg[n] = make_float2(conv3_at(pv, n, LSEQ, vw0, vw1, vw2, vb), conv3_at(pv + LSEQ, n, LSEQ, vw0, vw1, vw2, vb));
  }
#pragma unroll 1
  for (int o = 0; o < 2; ++o) {
    const float* tl = taps + (size_t)(o * 2048 + c) * LSEQ;
    const float* th = taps + (size_t)(o * 2048 + 1024 + c) * LSEQ;
    const float bias = P.hy_bias[o * 1024 + c];
    float nrm = 0.f;
    __syncthreads();
#pragma unroll 8
    for (int i = 0; i < 32; ++i) {
      const int n = tid + NT * i;
      float lo = tl[n] * expf(-((float)n / 16383.f) * delta);
      float hi = n > 0 ? th[LSEQ - n] * expf(-((float)(LSEQ - n) / 16383.f) * delta) : 0.f;
      X[swz(n)] = make_float2(lo + hi, 0.f);
      nrm += fabsf(lo) + fabsf(hi);
    }
    const float norm = block_sum(nrm, red);
    fft_fwd(X, TW);
#pragma unroll
    for (int i = 0; i < 32; ++i) K[i] = X[swz(tid + NT * i)];
    __syncthreads();
#pragma unroll 8
    for (int i = 0; i < 32; ++i) X[swz(tid + NT * i)] = Zg[tid + NT * i];
    __syncthreads();
    fft_fwd(X, TW);
#pragma unroll
    for (int i = 0; i < 32; ++i) { const int n = tid + NT * i; X[swz(n)] = cmul(X[swz(n)], K[i]); }
    __syncthreads();
    fft_inv(X, TW);
#pragma unroll 8
    for (int i = 0; i < 32; ++i) Rg[tid + NT * i] = X[swz(tid + NT * i)];
    __syncthreads();
#pragma unroll 8
    for (int i = 0; i < 32; ++i) {
      const int n = tid + NT * i;
      float lo = tl[n] * expf(-((float)n / 16383.f) * delta);
      float hi = n > 0 ? th[LSEQ - n] * expf(-((float)(LSEQ - n) / 16383.f) * delta) : 0.f;
      float2 h = HF[n];
      float dd = lo - hi;
      X[swz(n)] = make_float2(dd * h.x, dd * h.y);
    }
    __syncthreads();
    fft_fwd(X, TW);
#pragma unroll
    for (int i = 0; i < 32; ++i) K[i] = X[swz(tid + NT * i)];
    __syncthreads();
#pragma unroll 8
    for (int i = 0; i < 32; ++i) { const int n = tid + NT * i; X[swz(n)] = cmul(Zg[n], HF[n]); }
    __syncthreads();
    fft_fwd(X, TW);
#pragma unroll
    for (int i = 0; i < 32; ++i) { const int n = tid + NT * i; X[swz(n)] = cmul(X[swz(n)], K[i]); }
    __syncthreads();
    fft_inv(X, TW);
    const float sc = 0.5f / (16384.f * norm);
#pragma unroll 8
    for (int i = 0; i < 32; ++i) {
      const int n = tid + NT * i;
      float2 t = cmulc(X[swz(n)], HF[n]);
      float2 rr = Rg[n], zz = Zg[n];
      float y0 = (rr.x + t.x) * sc + zz.x * bias;
      float y1 = (rr.y + t.y) * sc + zz.y * bias;
      if (o == 0) {
        Zg[n] = make_float2(conv3_at(px1, n, LSEQ, aw0, aw1, aw2, ab) * y0, conv3_at(px1 + LSEQ, n, LSEQ, aw0, aw1, aw2, ab) * y1);
      } else {
        float o0 = conv3_at(px2, n, LSEQ, bw0, bw1, bw2, bb) * y0;
        float o1 = conv3_at(px2 + LSEQ, n, LSEQ, bw0, bw1, bw2, bb) * y1;
        P.RP[(size_t)c * MALL + n] = f2bf(o0);
        P.RP[(size_t)c * MALL + LSEQ + n] = f2bf(o1);
      }
    }
    __syncthreads();
  }
}

__device__ __forceinline__ void hyena_ctx_channel(const Params& P, int c, char* smem) {
  float* Kf = (float*)smem;
  float* u = Kf + 1024;
  float* z = u + 512;
  float* red = z + 512;
  const int tid = tid_(), b = tid >> 8, t = tid & 255;
  const float dlo = -3.0701134573253944f, dhi = -15.350567286626972f;
  const float delta = fabsf(dlo + (dhi - dlo) * ((float)c / 1023.f));
  const float* cw = P.hy_conv_w; const float* cb = P.hy_conv_b;
  float nrm[2];
  __syncthreads();
  {
    const int o = b, n = t;
    float dec = expf(-((float)n / 255.f) * delta);
    float lo = P.tapsc[(size_t)(o * 2048 + c) * 256 + n] * dec;
    float hi = n > 0 ? P.tapsc[(size_t)(o * 2048 + 1024 + c) * 256 + n] * dec : 0.f;
    Kf[o * 512 + 256 + n] = lo;
    if (n > 0) Kf[o * 512 + 256 - n] = hi;
    float v = fabsf(lo) + fabsf(hi);
    v = wave_sum(v);
    if ((tid & 63) == 0) red[tid >> 6] = v;
  }
  const bf16_t* pv = P.RP + (size_t)c * MALL + MLAT + b * 256;
  const bf16_t* px1 = P.RP + (size_t)(1024 + c) * MALL + MLAT + b * 256;
  const bf16_t* px2 = P.RP + (size_t)(2048 + c) * MALL + MLAT + b * 256;
  u[b * 256 + t] = conv3_at(pv, t, 256, cw[c], cw[3072 + c], cw[6144 + c], cb[c]);
  __syncthreads();
  nrm[0] = red[0] + red[1] + red[2] + red[3];
  nrm[1] = red[4] + red[5] + red[6] + red[7];
  float acc = 0.f;
  for (int s = 0; s < 256; ++s) acc += Kf[256 + t - s] * u[b * 256 + s];
  float y1 = acc / nrm[0] + u[b * 256 + t] * P.hy_bias[c];
  float zz = conv3_at(px1, t, 256, cw[1024 + c], cw[3072 + 1024 + c], cw[6144 + 1024 + c], cb[1024 + c]) * y1;
  z[b * 256 + t] = zz;
  __syncthreads();
  acc = 0.f;
  for (int s = 0; s < 256; ++s) acc += Kf[512 + 256 + t - s] * z[b * 256 + s];
  float y2 = acc / nrm[1] + zz * P.hy_bias[1024 + c];
  float o2 = conv3_at(px2, t, 256, cw[2048 + c], cw[3072 + 2048 + c], cw[6144 + 2048 + c], cb[2048 + c]) * y2;
  P.RP[(size_t)c * MALL + MLAT + b * 256 + t] = f2bf(o2);
  __syncthreads();
}

__device__ __forceinline__ void hyena_transpose_phase(const Params& P, char* smem) {
  bf16_t* t = (bf16_t*)smem;
  const int tid = tid_();
  for (int tile = blockIdx.x; tile < 520 * 16; tile += gridDim.x) {
    const int r0 = (tile >> 4) * 64, c0 = (tile & 15) * 64;
    __syncthreads();
    {
      const int ch = tid >> 3, r8 = (tid & 7) * 8;
      bf16x8 v = *(const bf16x8*)(P.RP + (size_t)(c0 + ch) * MALL + r0 + r8);
#pragma unroll
      for (int j = 0; j < 8; ++j) t[(r8 + j) * 66 + ch] = (bf16_t)v[j];
    }
    __syncthreads();
    {
      const int r = tid >> 3, c8 = (tid & 7) * 8;
      bf16x8 o;
#pragma unroll
      for (int j = 0; j < 8; ++j) o[j] = (short)t[r * 66 + c8 + j];
      *(bf16x8*)(P.H + (size_t)(r0 + r) * 2048 + c0 + c8) = o;
    }
  }
  __syncthreads();
}

typedef float f32x2 __attribute__((ext_vector_type(2)));
__device__ __forceinline__ float dpp_add(float v, float src_unused) { return v; }
__device__ __forceinline__ float oct_sum(float v) {
  v += __int_as_float(__builtin_amdgcn_mov_dpp(__float_as_int(v), 0xB1, 0xf, 0xf, true));
  v += __int_as_float(__builtin_amdgcn_mov_dpp(__float_as_int(v), 0x4E, 0xf, 0xf, true));
  v += __int_as_float(__builtin_amdgcn_mov_dpp(__float_as_int(v), 0x141, 0xf, 0xf, true));
  return v;
}
__device__ __forceinline__ void rwkv_scan_task(const Params& P, int task, char* smem) {
  const int tid = tid_(), wave = __builtin_amdgcn_readfirstlane(tid >> 6), lane = tid & 63;
  const int hf = task & 1, dir = (task >> 1) & 1, h = (task >> 2) & 15, b = task >> 6;
  const bf16_t* prw = P.RP + (size_t)3072 * MALL;
  bf16_t* W2t = (bf16_t*)smem;
  bf16_t* A2t = W2t + 64 * 104;
  bf16_t* Aw = A2t + 64 * 104;
  bf16_t* Aa = Aw + 32 * 104;
  float* cst = (float*)(Aa + 32 * 104);
  float* fb = cst + 320;
  float* ybufs = fb + 2 * 11264;
  bf16_t* yout = P.RA + (size_t)dir * MALL * 1024;
  __syncthreads();
  for (int i = tid; i < 96 * 64; i += NT) {
    int r = i >> 6, d = i & 63;
    W2t[d * 104 + r] = f2bf(P.rw_w2[(size_t)(dir * 96 + r) * 1024 + h * 64 + d]);
    A2t[d * 104 + r] = f2bf(P.rw_a2[(size_t)(dir * 96 + r) * 1024 + h * 64 + d]);
  }
  if (tid < 64) {
    cst[tid] = P.rw_w0[dir * 1024 + h * 64 + tid];
    cst[64 + tid] = P.rw_a0[dir * 1024 + h * 64 + tid];
    cst[128 + tid] = P.rw_k_k[h * 64 + tid];
    cst[192 + tid] = P.rw_k_a[h * 64 + tid];
    cst[256 + tid] = P.rw_r_k[h * 64 + tid];
  }
  __syncthreads();
  if (wave >= 4) {
    __builtin_amdgcn_s_setprio(3);
    const int rw = (wave - 4) * 8 + (lane >> 3), q = lane & 7;
    f32x2 S[4];
#pragma unroll
    for (int i = 0; i < 4; ++i) S[i] = (f32x2){0.f, 0.f};
    __syncthreads(); __syncthreads(); __syncthreads();
#define RWC_LOAD(J, K4, D4, A4, E4, R4, VV) do { const float* fj = F + (J) * 64 + 8 * q; \
      _Pragma("unroll") for (int i = 0; i < 2; ++i) { K4[i] = ((const float4*)(fj + 6144))[i]; D4[i] = ((const float4*)fj)[i]; A4[i] = ((const float4*)(fj + 4096))[i]; \
        E4[i] = ((const float4*)(fj + 2048))[i]; R4[i] = ((const float4*)(fj + 8192))[i]; } VV = F[10240 + (J) * 32 + rw]; } while (0)
#define LO2(X) ((f32x2){(X).x, (X).y})
#define HI2(X) ((f32x2){(X).z, (X).w})
#define RWC_STEP(J, K4, D4, A4, E4, R4, VV) do { \
      f32x2 sp = S[0] * LO2(K4[0]); sp = S[1] * HI2(K4[0]) + sp; sp = S[2] * LO2(K4[1]) + sp; sp = S[3] * HI2(K4[1]) + sp; \
      const float sa = -oct_sum(sp.x + sp.y); \
      const f32x2 sa2 = (f32x2){sa, sa}, vv2 = (f32x2){VV, VV}; \
      f32x2 t0 = vv2 * LO2(E4[0]), t1 = vv2 * HI2(E4[0]), t2 = vv2 * LO2(E4[1]), t3 = vv2 * HI2(E4[1]); \
      t0 = sa2 * LO2(A4[0]) + t0; t1 = sa2 * HI2(A4[0]) + t1; t2 = sa2 * LO2(A4[1]) + t2; t3 = sa2 * HI2(A4[1]) + t3; \
      S[0] = S[0] * LO2(D4[0]) + t0; S[1] = S[1] * HI2(D4[0]) + t1; S[2] = S[2] * LO2(D4[1]) + t2; S[3] = S[3] * HI2(D4[1]) + t3; \
      f32x2 yp = S[0] * LO2(R4[0]); yp = S[1] * HI2(R4[0]) + yp; yp = S[2] * LO2(R4[1]) + yp; yp = S[3] * HI2(R4[1]) + yp; \
      const float y = oct_sum(yp.x + yp.y); \
      if (q == 0) yb[(J) * 32 + rw] = y; } while (0)
#pragma unroll 1
    for (int ci = 0; ci < 520; ++ci) {
      const float* F = fb + (ci & 1) * 11264;
      float* yb = ybufs + (ci & 1) * 1024;
      float4 kA[2], dA[2], aA[2], eA[2], rA[2], kB[2], dB[2], aB[2], eB[2], rB[2];
      float vA, vB;
      RWC_LOAD(0, kA, dA, aA, eA, rA, vA);
#pragma unroll 1
      for (int j = 0; j < 32; j += 2) {
        RWC_LOAD(j + 1, kB, dB, aB, eB, rB, vB);
        RWC_STEP(j, kA, dA, aA, eA, rA, vA);
        if (j + 2 < 32) RWC_LOAD(j + 2, kA, dA, aA, eA, rA, vA);
        RWC_STEP(j + 1, kB, dB, aB, eB, rB, vB);
        if (j == 14 || j == 22 || j == 30) __syncthreads();
      }
    }
#undef RWC_LOAD
#undef RWC_STEP
#undef LO2
#undef HI2
    __builtin_amdgcn_s_setprio(0);
  } else {
    int itok[6], icol[6], ikind[6];
#pragma unroll
    for (int i = 0; i < 6; ++i) {
      const int id = tid + 256 * i;
      int kind = -1, tok = 0, col = 0;
      if (id < 640) {
        tok = id / 20; const int rem = id % 20;
        if (rem < 8) { kind = 0; col = h * 64 + rem * 8; }
        else if (rem < 16) { kind = 1; col = 1024 + h * 64 + (rem - 8) * 8; }
        else { kind = 2; col = 2048 + h * 64 + hf * 32 + (rem - 16) * 8; }
      } else if (id < 1408) {
        const int id2 = id - 640; tok = id2 / 24; const int rem = id2 % 24, which = rem / 12, k8 = (rem % 12) * 8;
        col = (which ? 3264 : 3072) + dir * 96 + k8; kind = 3 + which;
      }
      itok[i] = tok; icol[i] = col; ikind[i] = kind;
    }
    bf16x8 lc[6], lp[6], ln[6];
    const bf16x8 z8 = {0, 0, 0, 0, 0, 0, 0, 0};
#define RW_ISSUE(CI) do { _Pragma("unroll") for (int i = 0; i < 6; ++i) { lc[i] = z8; lp[i] = z8; ln[i] = z8; \
      if (ikind[i] >= 0 && (CI) < 520) { int pos, len; const int row = step_row((CI) * 32 + itok[i], b, dir, pos, len); \
        const bf16_t* p = prw + (size_t)row * 3712 + icol[i]; lc[i] = *(const bf16x8*)p; \
        if (pos > 0) lp[i] = *(const bf16x8*)(p - 3712); if (pos < len - 1) ln[i] = *(const bf16x8*)(p + 3712); } } } while (0)
    RW_ISSUE(0);
#pragma unroll 1
    for (int ci = -1; ci < 520; ++ci) {
      const int cn = ci + 1;
      float* F = fb + (cn & 1) * 11264;
      if (cn < 520) {
#pragma unroll
        for (int i = 0; i < 6; ++i) {
          if (ikind[i] >= 0) {
            const float4 m0 = *(const float4*)(P.rw_mu + icol[i]), m1 = *(const float4*)(P.rw_mu + icol[i] + 4);
            const float mu[8] = {m0.x, m0.y, m0.z, m0.w, m1.x, m1.y, m1.z, m1.w};
            float vv[8];
#pragma unroll
            for (int j = 0; j < 8; ++j) {
              float cc = bf2f((bf16_t)lc[i][j]), pp = bf2f((bf16_t)lp[i][j]), nn = bf2f((bf16_t)ln[i][j]);
              vv[j] = cc + (0.5f * (pp + nn) - cc) * mu[j];
            }
            const int tok = itok[i], c8 = icol[i] & 63;
            if (ikind[i] == 0) {
              *(float4*)(F + 8192 + tok * 64 + c8) = make_float4(vv[0], vv[1], vv[2], vv[3]);
              *(float4*)(F + 8192 + tok * 64 + c8 + 4) = make_float4(vv[4], vv[5], vv[6], vv[7]);
            } else if (ikind[i] == 1) {
              *(float4*)(F + 2048 + tok * 64 + c8) = make_float4(vv[0], vv[1], vv[2], vv[3]);
              *(float4*)(F + 2048 + tok * 64 + c8 + 4) = make_float4(vv[4], vv[5], vv[6], vv[7]);
            } else if (ikind[i] == 2) {
              *(float4*)(F + 10240 + tok * 32 + (c8 & 31)) = make_float4(vv[0], vv[1], vv[2], vv[3]);
              *(float4*)(F + 10240 + tok * 32 + (c8 & 31) + 4) = make_float4(vv[4], vv[5], vv[6], vv[7]);
            } else {
              const int k8 = (icol[i] - (ikind[i] == 3 ? 3072 : 3264) - dir * 96);
              bf16x8 o;
              if (ikind[i] == 3) {
#pragma unroll
                for (int j = 0; j < 8; ++j) o[j] = (short)f2bf(2.f * fsig(2.f * vv[j]) - 1.f);
                *(bf16x8*)(Aw + tok * 104 + k8) = o;
              } else {
#pragma unroll
                for (int j = 0; j < 8; ++j) o[j] = (short)f2bf(vv[j]);
                *(bf16x8*)(Aa + tok * 104 + k8) = o;
              }
            }
          }
        }
      }
      RW_ISSUE(cn + 1);
      __syncthreads();
      if (cn < 520) {
        const int fr = lane & 15, fq = lane >> 4;
#pragma unroll 1
        for (int tt = wave; tt < 16; tt += 4) {
          const int mat = tt >> 3, mt = (tt >> 2) & 1, nt = tt & 3;
          const bf16_t* As = mat ? Aa : Aw;
          const bf16_t* Bs = mat ? A2t : W2t;
          f32x4 acc = {0.f, 0.f, 0.f, 0.f};
#pragma unroll
          for (int ks = 0; ks < 3; ++ks) {
            bf16x8 a = *(const bf16x8*)(As + (mt * 16 + fr) * 104 + ks * 32 + fq * 8);
            bf16x8 bb = *(const bf16x8*)(Bs + (nt * 16 + fr) * 104 + ks * 32 + fq * 8);
            acc = __builtin_amdgcn_mfma_f32_16x16x32_bf16(bb, a, acc, 0, 0, 0);
          }
          const int tok = mt * 16 + fr, d0 = nt * 16 + fq * 4;
          float4 c4 = *(const float4*)(cst + mat * 64 + d0), o4;
          if (mat == 0) {
            o4.x = __expf(-0.6065306597126334f * fsig(c4.x + acc[0])); o4.y = __expf(-0.6065306597126334f * fsig(c4.y + acc[1]));
            o4.z = __expf(-0.6065306597126334f * fsig(c4.z + acc[2])); o4.w = __expf(-0.6065306597126334f * fsig(c4.w + acc[3]));
            *(float4*)(F + tok * 64 + d0) = o4;
          } else {
            o4.x = fsig(c4.x + acc[0]); o4.y = fsig(c4.y + acc[1]); o4.z = fsig(c4.z + acc[2]); o4.w = fsig(c4.w + acc[3]);
            *(float4*)(F + 4096 + tok * 64 + d0) = o4;
          }
        }
      }
      __syncthreads();
      if (ci >= 1) {
        const float* yb = ybufs + ((ci - 1) & 1) * 1024;
#pragma unroll
        for (int r = 0; r < 4; ++r) {
          const int id = tid + 256 * r, tok = id >> 5, vx = id & 31;
          int pos, len; const int row = step_row((ci - 1) * 32 + tok, b, dir, pos, len);
          yout[(size_t)row * 1024 + h * 64 + hf * 32 + vx] = f2bf(yb[id]);
        }
      }
      if (cn < 520) {
#pragma unroll 1
        for (int it = tid; it < 512; it += 256) {
          const int tok = it >> 4, d4 = (it & 15) * 4;
          const float4 k4 = *(const float4*)(F + 2048 + tok * 64 + d4), a4 = *(const float4*)(F + 4096 + tok * 64 + d4), r4 = *(const float4*)(F + 8192 + tok * 64 + d4);
          const float4 ck = *(const float4*)(cst + 128 + d4), ca = *(const float4*)(cst + 192 + d4), cr = *(const float4*)(cst + 256 + d4);
          const float kv[4] = {k4.x, k4.y, k4.z, k4.w}, av[4] = {a4.x, a4.y, a4.z, a4.w}, rv[4] = {r4.x, r4.y, r4.z, r4.w};
          const float ckv[4] = {ck.x, ck.y, ck.z, ck.w}, cav[4] = {ca.x, ca.y, ca.z, ca.w}, crv[4] = {cr.x, cr.y, cr.z, cr.w};
          float kkv[4], kd[4], ss = 0.f, bn = 0.f;
#pragma unroll
          for (int j = 0; j < 4; ++j) {
            kkv[j] = kv[j] * ckv[j];
            ss += kkv[j] * kkv[j];
            kd[j] = kv[j] * (1.f + (av[j] - 1.f) * cav[j]);
            bn += rv[j] * kd[j] * crv[j];
          }
#pragma unroll
          for (int m = 8; m >= 1; m >>= 1) { ss += __shfl_xor(ss, m); bn += __shfl_xor(bn, m); }
          const float inv = rsqrtf(fmaxf(ss, 1e-24f));
          *(float4*)(F + 6144 + tok * 64 + d4) = make_float4(kkv[0] * inv, kkv[1] * inv, kkv[2] * inv, kkv[3] * inv);
          *(float4*)(F + 2048 + tok * 64 + d4) = make_float4(kd[0], kd[1], kd[2], kd[3]);
          *(float4*)(F + 4096 + tok * 64 + d4) = make_float4(kkv[0] * inv * av[0], kkv[1] * inv * av[1], kkv[2] * inv * av[2], kkv[3] * inv * av[3]);
          if (hf == 0 && (it & 15) == 0) {
            int pos, len; const int row = step_row(cn * 32 + tok, b, dir, pos, len);
            P.bonus[((size_t)dir * MALL + row) * 16 + h] = bn;
          }
        }
      }
      __syncthreads();
    }
#undef RW_ISSUE
  }
  __syncthreads();
  {
    const float* yb = ybufs + (519 & 1) * 1024;
#pragma unroll
    for (int r = 0; r < 2; ++r) {
      const int id = tid + NT * r, tok = id >> 5, vx = id & 31;
      int pos, len; const int row = step_row(519 * 32 + tok, b, dir, pos, len);
      yout[(size_t)row * 1024 + h * 64 + hf * 32 + vx] = f2bf(yb[id]);
    }
  }
  __syncthreads();
}

__device__ __forceinline__ void rwkv_readout_phase(const Params& P) {
  const int tid = tid_(), wave = tid >> 6, lane = tid & 63;
  const bf16_t* __restrict__ prw = P.RP + (size_t)3072 * MALL;
  const bf16_t* __restrict__ yf = P.RA; const bf16_t* __restrict__ yb = P.RA + (size_t)MALL * 1024; const bf16_t* __restrict__ g = P.RA + (size_t)2 * MALL * 1024;
  bf16_t* __restrict__ Hout = P.H;
  for (int row = blockIdx.x * 8 + wave; row < MALL; row += gridDim.x * 8)
#pragma unroll
  for (int hq = 0; hq < 4; ++hq) {
    const int h = hq * 4 + (lane >> 4), d4 = (lane & 15) * 4, col = h * 64 + d4;
    int pos, len; row_info(row, pos, len);
    uint2 uf = *(const uint2*)(yf + (size_t)row * 1024 + col), ub = *(const uint2*)(yb + (size_t)row * 1024 + col);
    float y[4];
    y[0] = bf2f(uf.x & 0xffff) + bf2f(ub.x & 0xffff); y[1] = bf2f(uf.x >> 16) + bf2f(ub.x >> 16);
    y[2] = bf2f(uf.y & 0xffff) + bf2f(ub.y & 0xffff); y[3] = bf2f(uf.y >> 16) + bf2f(ub.y >> 16);
    float s = y[0] + y[1] + y[2] + y[3];
#pragma unroll
    for (int m = 8; m >= 1; m >>= 1) s += __shfl_xor(s, m);
    const float mean = s * (1.f / 64.f);
    float vs = 0.f;
#pragma unroll
    for (int j = 0; j < 4; ++j) { float dd = y[j] - mean; vs += dd * dd; }
#pragma unroll
    for (int m = 8; m >= 1; m >>= 1) vs += __shfl_xor(vs, m);
    const float rs = rsqrtf(vs * (1.f / 64.f) + 64e-5f);
    const float bn = P.bonus[(size_t)row * 16 + h] + P.bonus[((size_t)MALL + row) * 16 + h];
    const bf16_t* pp = prw + (size_t)row * 3712 + 2048 + col;
    uint2 cu = *(const uint2*)pp, z2 = make_uint2(0, 0);
    uint2 pu = pos > 0 ? *(const uint2*)(pp - 3712) : z2;
    uint2 nu = pos < len - 1 ? *(const uint2*)(pp + 3712) : z2;
    float cv[4] = {bf2f(cu.x & 0xffff), bf2f(cu.x >> 16), bf2f(cu.y & 0xffff), bf2f(cu.y >> 16)};
    float pv[4] = {bf2f(pu.x & 0xffff), bf2f(pu.x >> 16), bf2f(pu.y & 0xffff), bf2f(pu.y >> 16)};
    float nv[4] = {bf2f(nu.x & 0xffff), bf2f(nu.x >> 16), bf2f(nu.y & 0xffff), bf2f(nu.y >> 16)};
    uint2 gu = *(const uint2*)(g + (size_t)row * 1024 + col);
    float gv[4] = {bf2f(gu.x & 0xffff), bf2f(gu.x >> 16), bf2f(gu.y & 0xffff), bf2f(gu.y >> 16)};
    float o[4];
#pragma unroll
    for (int j = 0; j < 4; ++j) {
      float vsh = cv[j] + (0.5f * (pv[j] + nv[j]) - cv[j]) * P.rw_mu[2048 + col + j];
      float ln = (y[j] - mean) * rs * P.rw_ln_w[col + j] + P.rw_ln_b[col + j];
      o[j] = (ln + bn * vsh) * gv[j];
    }
    uint2 u; u.x = pack2(o[0], o[1]); u.y = pack2(o[2], o[3]);
    *(uint2*)(Hout + (size_t)row * 2048 + 1024 + col) = u;
  }
}

__device__ __forceinline__ float row16_sum(float v) {
  v += __int_as_float(__builtin_amdgcn_mov_dpp(__float_as_int(v), 0xB1, 0xf, 0xf, true));
  v += __int_as_float(__builtin_amdgcn_mov_dpp(__float_as_int(v), 0x4E, 0xf, 0xf, true));
  v += __int_as_float(__builtin_amdgcn_mov_dpp(__float_as_int(v), 0x141, 0xf, 0xf, true));
  v += __int_as_float(__builtin_amdgcn_mov_dpp(__float_as_int(v), 0x140, 0xf, 0xf, true));
  return v;
}
__device__ __forceinline__ void hgrn2_block_task(const Params& P, int t, char* smem) {
  const int tid = tid_(), wave = __builtin_amdgcn_readfirstlane(tid >> 6), lane = tid & 63;
  const int chain = t >> 3, vb = (t & 7) * 16, dir = chain & 1, h = (chain >> 1) & 7, b = chain >> 4;
  const bf16_t* p1 = P.RP;
  float* bufs = (float*)smem;
  __syncthreads();
  if (wave < 4) {
    __builtin_amdgcn_s_setprio(2);
    const int vi = lane >> 4, eg = lane & 15;
    bf16_t* oout = P.RA + (size_t)dir * MALL * 1024 + h * 128 + vb + wave * 4 + vi;
    const int rstep = dir ? -1 : 1;
    f32x2 S[4];
#pragma unroll
    for (int i = 0; i < 4; ++i) S[i] = (f32x2){0.f, 0.f};
    __syncthreads();
#pragma unroll 1
    for (int ci = 0; ci < 520; ++ci) {
      const float* B = bufs + (ci & 1) * 8704;
#pragma unroll 1
      for (int g = 0; g < 4; ++g) {
        int pos, len; const int r0 = step_row(ci * 32 + g * 8, b, dir, pos, len);
        float pov[8];
#pragma unroll
        for (int u = 0; u < 8; ++u) {
          const int s = g * 8 + u;
          const float4 qa = *(const float4*)(B + s * 128 + eg * 8), qb = *(const float4*)(B + s * 128 + eg * 8 + 4);
          const float4 ka = *(const float4*)(B + 4096 + s * 128 + eg * 8), kb = *(const float4*)(B + 4096 + s * 128 + eg * 8 + 4);
          const float vf = B[8192 + s * 16 + wave * 4 + vi];
          const f32x2 v2 = (f32x2){vf, vf};
          S[0] = (f32x2){ka.x, ka.y} * (v2 - S[0]) + S[0]; S[1] = (f32x2){ka.z, ka.w} * (v2 - S[1]) + S[1];
          S[2] = (f32x2){kb.x, kb.y} * (v2 - S[2]) + S[2]; S[3] = (f32x2){kb.z, kb.w} * (v2 - S[3]) + S[3];
          f32x2 po = (f32x2){qa.x, qa.y} * S[0];
          po = (f32x2){qa.z, qa.w} * S[1] + po; po = (f32x2){qb.x, qb.y} * S[2] + po; po = (f32x2){qb.z, qb.w} * S[3] + po;
          pov[u] = po.x + po.y;
        }
#pragma unroll
        for (int u = 0; u < 8; ++u) pov[u] += __int_as_float(__builtin_amdgcn_mov_dpp(__float_as_int(pov[u]), 0xB1, 0xf, 0xf, true));
#pragma unroll
        for (int u = 0; u < 8; ++u) pov[u] += __int_as_float(__builtin_amdgcn_mov_dpp(__float_as_int(pov[u]), 0x4E, 0xf, 0xf, true));
#pragma unroll
        for (int u = 0; u < 8; ++u) pov[u] += __int_as_float(__builtin_amdgcn_mov_dpp(__float_as_int(pov[u]), 0x141, 0xf, 0xf, true));
#pragma unroll
        for (int u = 0; u < 8; ++u) pov[u] += __int_as_float(__builtin_amdgcn_mov_dpp(__float_as_int(pov[u]), 0x140, 0xf, 0xf, true));
        if (eg == 0) {
#pragma unroll
          for (int u = 0; u < 8; ++u) oout[(size_t)(r0 + rstep * u) * 1024] = f2bf(pov[u]);
        }
      }
      __syncthreads();
    }
    __builtin_amdgcn_s_setprio(0);
  } else {
    const int pt = tid - 256;
    const int st0 = pt >> 4, c8 = (pt & 15) * 8;
    bf16x8 lq[2], lk[2], lv;
    const bf16x8 z8 = {0, 0, 0, 0, 0, 0, 0, 0};
#define HGP_ISSUE(CI) do { lq[0] = z8; lq[1] = z8; lk[0] = z8; lk[1] = z8; lv = z8; if ((CI) < 520) { \
      _Pragma("unroll") for (int r = 0; r < 2; ++r) { int pos, len; const int row = step_row((CI) * 32 + st0 + 16 * r, b, dir, pos, len); \
        const bf16_t* rp = p1 + (size_t)row * 7168; lq[r] = *(const bf16x8*)(rp + h * 128 + c8); lk[r] = *(const bf16x8*)(rp + 1024 + dir * 1024 + h * 128 + c8); } \
      if (pt < 64) { int pos, len; const int row = step_row((CI) * 32 + (pt >> 1), b, dir, pos, len); \
        lv = *(const bf16x8*)(p1 + (size_t)row * 7168 + 3072 + h * 128 + vb + (pt & 1) * 8); } } } while (0)
    HGP_ISSUE(0);
#pragma unroll 1
    for (int ci = -1; ci < 520; ++ci) {
      const int cn = ci + 1;
      float* B = bufs + (cn & 1) * 8704;
      if (cn < 520) {
#pragma unroll
        for (int r = 0; r < 2; ++r) {
          float qf[8], kf[8];
          unpack8(lq[r], qf); unpack8(lk[r], kf);
          float* dq = B + (st0 + 16 * r) * 128 + c8;
          *(float4*)dq = make_float4(qf[0], qf[1], qf[2], qf[3]); *(float4*)(dq + 4) = make_float4(qf[4], qf[5], qf[6], qf[7]);
          *(float4*)(dq + 4096) = make_float4(kf[0], kf[1], kf[2], kf[3]); *(float4*)(dq + 4100) = make_float4(kf[4], kf[5], kf[6], kf[7]);
        }
        if (pt < 64) {
          float vf[8]; unpack8(lv, vf);
          float* dv = B + 8192 + (pt >> 1) * 16 + (pt & 1) * 8;
          *(float4*)dv = make_float4(vf[0], vf[1], vf[2], vf[3]); *(float4*)(dv + 4) = make_float4(vf[4], vf[5], vf[6], vf[7]);
        }
      }
      HGP_ISSUE(cn + 1);
      __syncthreads();
    }
#undef HGP_ISSUE
  }
  __syncthreads();
}

__device__ __forceinline__ void hgrn2_block_task32(const Params& P, int t, char* smem) {
  const int tid = tid_(), wave = __builtin_amdgcn_readfirstlane(tid >> 6), lane = tid & 63;
  const int chain = t >> 2, vb = (t & 3) * 32, dir = chain & 1, h = (chain >> 1) & 7, b = chain >> 4;
  const bf16_t* p1 = P.RP;
  float* bufs = (float*)smem;
  __syncthreads();
  if (wave < 4) {
    __builtin_amdgcn_s_setprio(2);
    const int vi = lane >> 4, eg = lane & 15;
    bf16_t* oout = P.RA + (size_t)dir * MALL * 1024 + h * 128 + vb + wave * 8 + vi;
    const int rstep = dir ? -1 : 1;
    f32x2 S0[4], S1[4];
#pragma unroll
    for (int i = 0; i < 4; ++i) { S0[i] = (f32x2){0.f, 0.f}; S1[i] = (f32x2){0.f, 0.f}; }
    __syncthreads();
#pragma unroll 1
    for (int ci = 0; ci < 520; ++ci) {
      const float* B = bufs + (ci & 1) * 9216;
#pragma unroll 1
      for (int g = 0; g < 4; ++g) {
        int pos, len; const int r0 = step_row(ci * 32 + g * 8, b, dir, pos, len);
        float pa[8], pb[8];
#pragma unroll
        for (int u = 0; u < 8; ++u) {
          const int s = g * 8 + u;
          const float4 qa = *(const float4*)(B + s * 128 + eg * 8), qb = *(const float4*)(B + s * 128 + eg * 8 + 4);
          const float4 ka = *(const float4*)(B + 4096 + s * 128 + eg * 8), kb = *(const float4*)(B + 4096 + s * 128 + eg * 8 + 4);
          const float vf0 = B[8192 + s * 32 + wave * 8 + vi], vf1 = B[8192 + s * 32 + wave * 8 + 4 + vi];
          const f32x2 v0 = (f32x2){vf0, vf0}, v1 = (f32x2){vf1, vf1};
          const f32x2 k0 = (f32x2){ka.x, ka.y}, k1 = (f32x2){ka.z, ka.w}, k2 = (f32x2){kb.x, kb.y}, k3 = (f32x2){kb.z, kb.w};
          const f32x2 q0 = (f32x2){qa.x, qa.y}, q1 = (f32x2){qa.z, qa.w}, q2 = (f32x2){qb.x, qb.y}, q3 = (f32x2){qb.z, qb.w};
          S0[0] = k0 * (v0 - S0[0]) + S0[0]; S0[1] = k1 * (v0 - S0[1]) + S0[1]; S0[2] = k2 * (v0 - S0[2]) + S0[2]; S0[3] = k3 * (v0 - S0[3]) + S0[3];
          S1[0] = k0 * (v1 - S1[0]) + S1[0]; S1[1] = k1 * (v1 - S1[1]) + S1[1]; S1[2] = k2 * (v1 - S1[2]) + S1[2]; S1[3] = k3 * (v1 - S1[3]) + S1[3];
          f32x2 po = q0 * S0[0]; po = q1 * S0[1] + po; po = q2 * S0[2] + po; po = q3 * S0[3] + po;
          f32x2 pp = q0 * S1[0]; pp = q1 * S1[1] + pp; pp = q2 * S1[2] + pp; pp = q3 * S1[3] + pp;
          pa[u] = po.x + po.y; pb[u] = pp.x + pp.y;
        }
#pragma unroll
        for (int u = 0; u < 8; ++u) { pa[u] += __int_as_float(__builtin_amdgcn_mov_dpp(__float_as_int(pa[u]), 0xB1, 0xf, 0xf, true)); pb[u] += __int_as_float(__builtin_amdgcn_mov_dpp(__float_as_int(pb[u]), 0xB1, 0xf, 0xf, true)); }
#pragma unroll
        for (int u = 0; u < 8; ++u) { pa[u] += __int_as_float(__builtin_amdgcn_mov_dpp(__float_as_int(pa[u]), 0x4E, 0xf, 0xf, true)); pb[u] += __int_as_float(__builtin_amdgcn_mov_dpp(__float_as_int(pb[u]), 0x4E, 0xf, 0xf, true)); }
#pragma unroll
        for (int u = 0; u < 8; ++u) { pa[u] += __int_as_float(__builtin_amdgcn_mov_dpp(__float_as_int(pa[u]), 0x141, 0xf, 0xf, true)); pb[u] += __int_as_float(__builtin_amdgcn_mov_dpp(__float_as_int(pb[u]), 0x141, 0xf, 0xf, true)); }
#pragma unroll
        for (int u = 0; u < 8; ++u) { pa[u] += __int_as_float(__builtin_amdgcn_mov_dpp(__float_as_int(pa[u]), 0x140, 0xf, 0xf, true)); pb[u] += __int_as_float(__builtin_amdgcn_mov_dpp(__float_as_int(pb[u]), 0x140, 0xf, 0xf, true)); }
        if (eg == 0) {
#pragma unroll
          for (int u = 0; u < 8; ++u) { bf16_t* op = oout + (size_t)(r0 + rstep * u) * 1024; op[0] = f2bf(pa[u]); op[4] = f2bf(pb[u]); }
        }
      }
      __syncthreads();
    }
    __builtin_amdgcn_s_setprio(0);
  } else {
    const int pt = tid - 256;
    const int st0 = pt >> 4, c8 = (pt & 15) * 8;
    bf16x8 lq[2], lk[2], lv;
    const bf16x8 z8 = {0, 0, 0, 0, 0, 0, 0, 0};
#define HGP_ISSUE(CI) do { lq[0] = z8; lq[1] = z8; lk[0] = z8; lk[1] = z8; lv = z8; if ((CI) < 520) { \
      _Pragma("unroll") for (int r = 0; r < 2; ++r) { int pos, len; const int row = step_row((CI) * 32 + st0 + 16 * r, b, dir, pos, len); \
        const bf16_t* rp = p1 + (size_t)row * 7168; lq[r] = *(const bf16x8*)(rp + h * 128 + c8); lk[r] = *(const bf16x8*)(rp + 1024 + dir * 1024 + h * 128 + c8); } \
      if (pt < 128) { int pos, len; const int row = step_row((CI) * 32 + (pt >> 2), b, dir, pos, len); \
        lv = *(const bf16x8*)(p1 + (size_t)row * 7168 + 3072 + h * 128 + vb + (pt & 3) * 8); } } } while (0)
    HGP_ISSUE(0);
#pragma unroll 1
    for (int ci = -1; ci < 520; ++ci) {
      const int cn = ci + 1;
      float* B = bufs + (cn & 1) * 9216;
      if (cn < 520) {
#pragma unroll
        for (int r = 0; r < 2; ++r) {
          float qf[8], kf[8];
          unpack8(lq[r], qf); unpack8(lk[r], kf);
          float* dq = B + (st0 + 16 * r) * 128 + c8;
          *(float4*)dq = make_float4(qf[0], qf[1], qf[2], qf[3]); *(float4*)(dq + 4) = make_float4(qf[4], qf[5], qf[6], qf[7]);
          *(float4*)(dq + 4096) = make_float4(kf[0], kf[1], kf[2], kf[3]); *(float4*)(dq + 4100) = make_float4(kf[4], kf[5], kf[6], kf[7]);
        }
        if (pt < 128) {
          float vf[8]; unpack8(lv, vf);
          float* dv = B + 8192 + (pt >> 2) * 32 + (pt & 3) * 8;
          *(float4*)dv = make_float4(vf[0], vf[1], vf[2], vf[3]); *(float4*)(dv + 4) = make_float4(vf[4], vf[5], vf[6], vf[7]);
        }
      }
      HGP_ISSUE(cn + 1);
      __syncthreads();
    }
#undef HGP_ISSUE
  }
  __syncthreads();
}

template <int PASS>
__device__ __forceinline__ void rglru_task(const Params& P, int task, char* smem) {
  const int tid = tid_(), wave = __builtin_amdgcn_readfirstlane(tid >> 6), lane = tid & 63;
  const int grp = task % 52, chainidx = task / 52, hd = chainidx & 15, dir = (chainidx >> 4) & 1, b = chainidx >> 5;
  const bf16_t* p1 = P.RP;
  bf16_t* hout = P.RA + (size_t)(2 + dir) * MALL * 1024 + hd * 64;
  float* sumA = P.rgsum + (size_t)chainidx * 52 * 128;
  bf16_t* Bt = (bf16_t*)smem;
  bf16_t* At = Bt + 128 * 72;
  float* xbf = (float*)(At + 64 * 72);
  float* G = xbf + 4096;
  float* cst = G + 4 * 4096;
  float* car = G + 2 * 4096;
  __syncthreads();
  for (int i = tid; i < 64 * 128; i += NT) {
    int k = i >> 7, n = i & 127;
    float w = n < 64 ? P.rg_wa[((size_t)(dir * 16 + hd) * 64 + k) * 64 + n] : P.rg_wx[((size_t)(dir * 16 + hd) * 64 + k) * 64 + (n - 64)];
    Bt[n * 72 + k] = f2bf(w);
  }
  if (tid < 64) {
    cst[tid] = P.rg_ba[(dir * 16 + hd) * 64 + tid];
    cst[64 + tid] = P.rg_bx[(dir * 16 + hd) * 64 + tid];
    float lam = P.rg_lam[dir * 1024 + hd * 64 + tid];
    cst[128 + tid] = 8.f * log1pf(expf(-lam));
    for (int k = 0; k < 4; ++k) cst[192 + k * 64 + tid] = P.rg_conv_w[k * 1024 + hd * 64 + tid];
    cst[448 + tid] = P.rg_conv_b[hd * 64 + tid];
  }
  if (PASS == 2) for (int i = tid; i < grp * 128; i += NT) car[i] = sumA[i];
  float hstate = 0.f, aprod = 1.f;
  bf16x8 xr[2][4];
  const bf16x8 z8 = {0, 0, 0, 0, 0, 0, 0, 0};
#define RG_GEOM(CI, RBASE, PBASE, LEN) int RBASE, PBASE, LEN; { int pos0_; const int rf_ = step_row((CI) * 64, b, dir, pos0_, LEN); RBASE = dir ? rf_ - 63 : rf_; PBASE = dir ? pos0_ - 63 : pos0_; }
#define RG_ISSUE(CI, T0, STRIDE) do { RG_GEOM(CI, rb_, pb_, ln_); _Pragma("unroll") for (int r = 0; r < 2; ++r) { const int id = (T0) + (STRIDE) * r; \
      _Pragma("unroll") for (int k = 0; k < 4; ++k) xr[r][k] = z8; \
      if ((T0) >= 0 && id < 512) { const int tk = id >> 3, c8 = (id & 7) * 8; const bf16_t* rp = p1 + (size_t)(rb_ + tk) * 7168 + 5120 + hd * 64 + c8; \
        _Pragma("unroll") for (int k = 0; k < 4; ++k) { const int pp = pb_ + tk + k - 2; if (pp >= 0 && pp < ln_) xr[r][k] = *(const bf16x8*)(rp + (ptrdiff_t)(k - 2) * 7168); } } } } while (0)
#define RG_CONV(T0, STRIDE) do { _Pragma("unroll") for (int r = 0; r < 2; ++r) { const int id = (T0) + (STRIDE) * r; \
      if ((T0) >= 0 && id < 512) { const int tk = id >> 3, c8 = (id & 7) * 8; float acc[8]; \
        _Pragma("unroll") for (int j = 0; j < 8; ++j) acc[j] = cst[448 + c8 + j]; \
        _Pragma("unroll") for (int k = 0; k < 4; ++k) { _Pragma("unroll") for (int j = 0; j < 8; ++j) acc[j] += bf2f((bf16_t)xr[r][k][j]) * cst[192 + k * 64 + c8 + j]; } \
        bf16x8 o; _Pragma("unroll") for (int j = 0; j < 8; ++j) { o[j] = (short)f2bf(acc[j]); xbf[tk * 64 + c8 + j] = acc[j]; } \
        *(bf16x8*)(At + tk * 72 + c8) = o; } } } while (0)
  __syncthreads();
  if (PASS == 2 && wave == 0) {
    for (int g = 0; g < grp; ++g) hstate = car[g * 128 + lane] * hstate + car[g * 128 + 64 + lane];
  }
  RG_ISSUE(grp * 5, tid, 512);
  RG_CONV(tid, 512);
  __syncthreads();
  const int t1 = tid - 64;
#pragma unroll 1
  for (int cc = 0; cc < 5; ++cc) {
    const int ci = grp * 5 + cc;
    float* Ga = G + (cc & 1) * 8192; float* Gu = Ga + 4096;
    if (cc + 1 < 5) RG_ISSUE(ci + 1, t1, 448);
    {
      const int mt = wave >> 1, jh = wave & 1, fr = lane & 15, fq = lane >> 4;
#pragma unroll
      for (int jj = 0; jj < 2; ++jj) {
        const int jt = jh * 2 + jj;
        f32x4 accr = {0.f, 0.f, 0.f, 0.f}, acci = {0.f, 0.f, 0.f, 0.f};
#pragma unroll
        for (int ks = 0; ks < 2; ++ks) {
          bf16x8 a = *(const bf16x8*)(At + (mt * 16 + fr) * 72 + ks * 32 + fq * 8);
          bf16x8 br = *(const bf16x8*)(Bt + (jt * 16 + fr) * 72 + ks * 32 + fq * 8);
          bf16x8 bi = *(const bf16x8*)(Bt + (64 + jt * 16 + fr) * 72 + ks * 32 + fq * 8);
          accr = __builtin_amdgcn_mfma_f32_16x16x32_bf16(br, a, accr, 0, 0, 0);
          acci = __builtin_amdgcn_mfma_f32_16x16x32_bf16(bi, a, acci, 0, 0, 0);
        }
        const int tk = mt * 16 + fr, j0 = jt * 16 + fq * 4;
        const float4 xb4 = *(const float4*)(xbf + tk * 64 + j0);
        const float xbv[4] = {xb4.x, xb4.y, xb4.z, xb4.w};
        float av[4], uv[4];
#pragma unroll
        for (int e = 0; e < 4; ++e) {
          const float ra = fsig(accr[e] + cst[j0 + e]), ix = fsig(acci[e] + cst[64 + j0 + e]);
          const float log_a = -ra * cst[128 + j0 + e];
          av[e] = __expf(log_a);
          uv[e] = sqrtf(-expm1f(2.f * log_a)) * ix * xbv[e];
        }
        *(float4*)(Ga + tk * 64 + j0) = make_float4(av[0], av[1], av[2], av[3]);
        *(float4*)(Gu + tk * 64 + j0) = make_float4(uv[0], uv[1], uv[2], uv[3]);
      }
    }
    __syncthreads();
    if (wave == 0) {
#pragma unroll 8
      for (int s = 0; s < 64; ++s) {
        const int tk = dir ? 63 - s : s;
        const float a = Ga[tk * 64 + lane];
        hstate = a * hstate + Gu[tk * 64 + lane];
        if (PASS == 1) aprod *= a; else Gu[tk * 64 + lane] = hstate;
      }
    } else {
      if (PASS == 2 && cc > 0) {
        RG_GEOM(ci - 1, rbp, pbp, lnp);
        const float* Gp = G + ((cc - 1) & 1) * 8192 + 4096;
        for (int id = t1; id < 4096; id += 448) hout[(size_t)(rbp + (id >> 6)) * 1024 + (id & 63)] = f2bf(Gp[id]);
      }
      if (cc + 1 < 5) RG_CONV(t1, 448);
    }
    __syncthreads();
  }
  if (PASS == 2) {
    RG_GEOM(grp * 5 + 4, rbp, pbp, lnp);
    const float* Gp = G + (4 & 1) * 8192 + 4096;
    for (int id = tid; id < 4096; id += NT) hout[(size_t)(rbp + (id >> 6)) * 1024 + (id & 63)] = f2bf(Gp[id]);
  }
  if (PASS == 1 && wave == 0) { sumA[grp * 128 + lane] = aprod; sumA[grp * 128 + 64 + lane] = hstate; }
  __syncthreads();
#undef RG_GEOM
#undef RG_ISSUE
#undef RG_CONV
}

__device__ __forceinline__ void l1_readout_phase(const Params& P) {
  const int tid = tid_(), wave = tid >> 6, lane = tid & 63;
  const bf16_t* __restrict__ p1 = P.RP;
  const bf16_t* __restrict__ of = P.RA; const bf16_t* __restrict__ ob = P.RA + (size_t)MALL * 1024;
  const bf16_t* __restrict__ hf = P.RA + (size_t)2 * MALL * 1024; const bf16_t* __restrict__ hb = P.RA + (size_t)3 * MALL * 1024;
  bf16_t* __restrict__ Hout = P.H;
  for (int row = blockIdx.x * 8 + wave; row < MLAT; row += gridDim.x * 8)
#pragma unroll
  for (int part = 0; part < 8; ++part) {
    if (part < 4) {
      const int col = part * 256 + lane * 4;
      uint2 a = *(const uint2*)(of + (size_t)row * 1024 + col), bq = *(const uint2*)(ob + (size_t)row * 1024 + col);
      float o[4] = {bf2f(a.x & 0xffff) + bf2f(bq.x & 0xffff), bf2f(a.x >> 16) + bf2f(bq.x >> 16),
                    bf2f(a.y & 0xffff) + bf2f(bq.y & 0xffff), bf2f(a.y >> 16) + bf2f(bq.y >> 16)};
      float ss = o[0] * o[0] + o[1] * o[1] + o[2] * o[2] + o[3] * o[3];
#pragma unroll
      for (int m = 16; m >= 1; m >>= 1) ss += __shfl_xor(ss, m);
      const float rs = rsqrtf(ss * (1.f / 128.f) + 1e-6f);
      uint2 gu = *(const uint2*)(p1 + (size_t)row * 7168 + 4096 + col);
      float gv[4] = {bf2f(gu.x & 0xffff), bf2f(gu.x >> 16), bf2f(gu.y & 0xffff), bf2f(gu.y >> 16)};
      float r[4];
#pragma unroll
      for (int j = 0; j < 4; ++j) r[j] = o[j] * rs * P.hg_norm_w[col + j] * gv[j];
      uint2 u; u.x = pack2(r[0], r[1]); u.y = pack2(r[2], r[3]);
      *(uint2*)(Hout + (size_t)row * 2048 + col) = u;
    } else {
      const int col = (part - 4) * 256 + lane * 4;
      uint2 a = *(const uint2*)(hf + (size_t)row * 1024 + col), bq = *(const uint2*)(hb + (size_t)row * 1024 + col);
      uint2 gu = *(const uint2*)(p1 + (size_t)row * 7168 + 6144 + col);
      float r0 = (bf2f(a.x & 0xffff) + bf2f(bq.x & 0xffff)) * bf2f(gu.x & 0xffff);
      float r1 = (bf2f(a.x >> 16) + bf2f(bq.x >> 16)) * bf2f(gu.x >> 16);
      float r2 = (bf2f(a.y & 0xffff) + bf2f(bq.y & 0xffff)) * bf2f(gu.y & 0xffff);
      float r3 = (bf2f(a.y >> 16) + bf2f(bq.y >> 16)) * bf2f(gu.y >> 16);
      uint2 u; u.x = pack2(r0, r1); u.y = pack2(r2, r3);
      *(uint2*)(Hout + (size_t)row * 2048 + 1024 + col) = u;
    }
  }
}

#define XB_TMO      128
#define XB_XCNT(j)  (256  + 64 * (j))
#define XB_XSUB(j)  (1280 + 64 * (j))
#define XB_XGEN(j)  (2304 + 64 * (j))
#define XB_TOP      3328
#define XB_TOPGEN   3392
#define XCD_BAR_WORDS 3456
#define XB_SPIN_CAP (1u << 18)
#ifndef LAS
#define LAS __attribute__((address_space(3)))
#endif

__device__ __forceinline__ unsigned xb_ld(unsigned* p)              { return __hip_atomic_load(p, __ATOMIC_RELAXED, __HIP_MEMORY_SCOPE_AGENT); }
__device__ __forceinline__ unsigned xb_add(unsigned* p, unsigned v) { return __hip_atomic_fetch_add(p, v, __ATOMIC_RELAXED, __HIP_MEMORY_SCOPE_AGENT); }
__device__ __forceinline__ unsigned xb_xcc_id() { return (unsigned)__builtin_amdgcn_s_getreg((3 << 11) | 20) & 0xFu; }
#define XB_SPIN(cond, bar) do { unsigned _sp = 0; while (cond) { __builtin_amdgcn_s_sleep(1); \
    if ((++_sp & 255u) == 0u) { if (xb_ld(&(bar)[XB_TMO])) break; if (_sp > XB_SPIN_CAP) { atomicAdd(&(bar)[XB_TMO], 1u); break; } } } } while (0)

struct XcdBarrier {
    unsigned* bar; unsigned x;
    volatile LAS unsigned* st;
};

__device__ __forceinline__ XcdBarrier xcd_barrier_post(unsigned* bar, volatile LAS unsigned* st) {
    XcdBarrier b; b.bar = bar; b.x = xb_xcc_id(); b.st = st;
    if (threadIdx.x == 0) (void)xb_add(&bar[XB_XCNT(b.x)], 1u);
    return b;
}
__device__ __forceinline__ void xcd_barrier_complete(unsigned* bar, unsigned x, unsigned& nloc, unsigned& nx) {
    const unsigned G = gridDim.x * gridDim.y * gridDim.z;
    unsigned sum, cnt, mine, sp = 0u;
    for (;;) {
        sum = 0u; cnt = 0u; mine = 0u;
#pragma unroll
        for (unsigned j = 0; j < 16; ++j) { const unsigned c = xb_ld(&bar[XB_XCNT(j)]); sum += c; cnt += (c > 0u) ? 1u : 0u; mine = (j == x) ? c : mine; }
        if (sum == G) break;
        __builtin_amdgcn_s_sleep(1);
        if ((++sp & 255u) == 0u) { if (xb_ld(&bar[XB_TMO])) break; if (sp > XB_SPIN_CAP) { atomicAdd(&bar[XB_TMO], 1u); break; } }
    }
    nloc = mine > 0u ? mine : 1u; nx = cnt > 0u ? cnt : 1u;
}

__device__ __forceinline__ void xcd_barrier(const XcdBarrier& b) {
    asm volatile("s_waitcnt vmcnt(0)" ::: "memory");
    __syncthreads();
    if (threadIdx.x == 0) {
        unsigned* bar = b.bar;
        __builtin_amdgcn_s_waitcnt(0);
        unsigned nloc = b.st[0], nx = b.st[1];
        if (nloc == 0u) { xcd_barrier_complete(bar, b.x, nloc, nx); b.st[0] = nloc; b.st[1] = nx; }
        const unsigned old = xb_add(&bar[XB_XSUB(b.x)], 1u);
        const unsigned gen = old / nloc;
        if (old + 1u == (gen + 1u) * nloc) {
            __builtin_amdgcn_fence(__ATOMIC_RELEASE, "agent");
            asm volatile("s_waitcnt vmcnt(0)" ::: "memory");
            const unsigned og = xb_add(&bar[XB_TOP], 1u);
            const unsigned tg = og / nx;
            if (og + 1u == (tg + 1u) * nx) xb_add(&bar[XB_TOPGEN], 1u);
            else XB_SPIN(xb_ld(&bar[XB_TOPGEN]) == tg, bar);
            __builtin_amdgcn_fence(__ATOMIC_ACQUIRE, "agent");
            xb_add(&bar[XB_XGEN(b.x)], 1u);
            asm volatile("s_waitcnt vmcnt(0)" ::: "memory");
        } else {
            XB_SPIN(xb_ld(&bar[XB_XGEN(b.x)]) == gen, bar);
            __builtin_amdgcn_fence(__ATOMIC_ACQUIRE, "agent");
            asm volatile("s_waitcnt vmcnt(0)" ::: "memory");
        }
    }
    __syncthreads();
}


__global__ void __launch_bounds__(NT) mega(Params P) {
  extern __shared__ __attribute__((aligned(16))) char smem[];
  cg::grid_group grid = cg::this_grid();
  const int G = gridDim.x, bid = blockIdx.x, tid = tid_();
  const float* mod0 = P.mod; const float* mod1 = P.mod + 3 * 12288;

  if (bid == 0 && tid == 0) { P.hyq[0] = 0; P.hyq[64] = 0; }
  if (bid == 0) for (int i = tid; i < XCD_BAR_WORDS; i += NT) P.xbar[i] = 0u;
  volatile LAS unsigned* xst = (volatile LAS unsigned*)(smem + 143360 - 16);
  if (tid == 0) { xst[0] = 0u; xst[1] = 0u; xst[2] = 0u; xst[3] = 0u; }
  __syncthreads();
  for (int t = bid; t < 192; t += G) adaln_task(P, smem, t);
  {
    int gb = 192;
    gb = cvt_run(P.ev_w_in, 2048, 6784, P.w_in_t, smem, gb);
    gb = cvt_run(P.ev_w_out, 2048, 2048, P.w_out_t, smem, gb);
    gb = cvt_run(P.mlp_w1, 2048, 8192, P.w1_t, smem, gb);
    gb = cvt_run(P.mlp_w2, 8192, 2048, P.w2_t, smem, gb);
    gb = cvt_run(P.hy_f_w3, 64, 4096, P.w3t, smem, gb);
    gb = cvt_run(P.rw_g2, 256, 1024, P.g2t, smem, gb);
  }
  hyena_h2_phase(P, smem);
  for (int i = bid * NT + tid; i < 32768; i += G * NT) {
    if (i < 16384) { float s, c; sincospif(-(float)i / 8192.f, &s, &c); P.tw[i] = make_float2(c, s); }
    else { int n = i - 16384; float s, c; sincospif(-(float)n / 16384.f, &s, &c); P.half[n] = make_float2(c, s); }
  }
  grid.sync();
  const XcdBarrier xb = xcd_barrier_post(P.xbar, xst);
  norm_phase(P.x, P.ctx, P.norm_w, mod0, 0, P.H, MALL, 0);
  xcd_barrier(xb);
  {
    int gb = 0;
    ALoadPlain aH{P.H, 2048};
    int rot = 0;
    rot = pg8_run(smem, P.w_in_t, P.H, 3072, MALL, 2048, PEpiBf16<ActNone>{P.RP, (size_t)MALL, MALL, ActNone{}}, rot);
    rot = pg8_run(smem, P.H, P.w_in_t + (size_t)3072 * 2048, MALL, 3840, 2048, PEpiBf16<ActNone>{P.RP + (size_t)3072 * MALL, 3712, 3712, ActNone{}}, rot);
    gb = rot;
    gb = gemm_run<true>(ALoadPlain{P.h2b, 64}, P.w3t, 64, LSEQ, 4096, EpTransF32{P.out, (size_t)LSEQ}, smem, gb);
    gb = gemm_run<true>(ALoadPlain{P.h2cb, 64}, P.w3t, 64, 256, 4096, EpTransF32{P.tapsc, 256}, smem, gb);
  }
  xcd_barrier(xb);
  {
    const int nR0 = G >= 256 ? 128 : 0;
    if (bid >= nR0) {
      _Pragma("unroll 1") for (int c = bid - nR0; c < 1024; c += G - nR0) hyena_ctx_channel(P, c, smem);
      gemm_run_r<false>(ALoadG{P.RP + (size_t)3072 * MALL, P.rw_mu}, P.g2t, 256, MALL, 1024, EpBf16{P.RA + (size_t)2 * MALL * 1024, 1024}, smem, bid - nR0, G - nR0);
    }
  }
  {
    const int nR = G >= 256 ? 128 : 0;
    if (nR) { if (bid < nR) rwkv_scan_task(P, bid, smem); }
    else { _Pragma("unroll 1") for (int t = bid; t < 128; t += G) rwkv_scan_task(P, t, smem); }
    __syncthreads();
    if (tid < 256) { float sn, cs; if (tid < 128) sincospif(-(float)tid / 64.f, &sn, &cs); else sincospif(-(float)(tid - 128) / 8192.f, &sn, &cs);
      ((float2*)(smem + 131072 + 1024))[tid] = make_float2(cs, sn); }
    _Pragma("unroll 1") for (;;) {
      int* cslot = (int*)(smem + 131072 + 512);
      __syncthreads();
      if (tid == 0) *cslot = atomicAdd(P.hyq, 1);
      __syncthreads();
      const int c = *cslot;
      if (c >= 1024) break;
      hyena_channel(P, c, smem);
    }
  }
  xcd_barrier(xb);
  rwkv_readout_phase(P);
  hyena_transpose_phase(P, smem);
  xcd_barrier(xb);
  pg8_run(smem, P.H, P.w_out_t, MLAT, 2048, 2048, PEpiResid{P.x, P.ctx, P.out, P.xc, mod0, 2, 0}, 0);
  pg8_ctx_splitk(smem, P.H + (size_t)MLAT * 2048, P.w_out_t, 2048, (float*)(P.RA + (size_t)50 * 1048576), 0);
  xcd_barrier(xb);
  norm_phase(P.out, P.ctx, P.norm_w + 2048, mod0, 3, P.H, MALL, 0, (float*)(P.RA + (size_t)50 * 1048576), mod0 + 2 * 12288 + 2 * 2048, P.xc);
  {
    int gb = 0;
    gb = cvt_run(P.od_w_in, 2048, 7168, P.w_in_t, smem, gb);
  }
  xcd_barrier(xb);
  pg8_run(smem, P.H, P.w1_t, MALL, 8192, 2048, PEpiBf16<ActSqRelu>{P.RP, 8192, 8192, ActSqRelu{}}, 0);
  xcd_barrier(xb);
  pg8_run(smem, P.RP, P.w2_t, MLAT, 2048, 8192, PEpiResid{P.out, P.xc, P.out, P.xc, mod0, 5, 0}, 0);
  pg8_ctx_splitk(smem, P.RP + (size_t)MLAT * 8192, P.w2_t, 8192, (float*)(P.RA + (size_t)50 * 1048576), 0);
  xcd_barrier(xb);
  norm_phase(P.out, P.xc, P.norm_w + 4096, mod1, 0, P.H, MALL, 1, (float*)(P.RA + (size_t)50 * 1048576), mod0 + 2 * 12288 + 5 * 2048, P.xc);
  xcd_barrier(xb);
  pg8_run(smem, P.H, P.w_in_t, MALL, 7168, 2048, PEpiBf16<ActIn1>{P.RP, 7168, 7168, ActIn1{P.hg_lb}}, 0);
  xcd_barrier(xb);
  if (G >= 256) {
    if (bid < 128) hgrn2_block_task32(P, bid, smem);
    else {
      const int nB = G - 128;
      _Pragma("unroll 1") for (int t = bid - 128; t < 3328; t += nB) rglru_task<1>(P, t, smem);
      __syncthreads();
      if (tid == 0) {
        __threadfence();
        atomicAdd(P.hyq + 64, 1);
        int spins = 0;
        while (atomicAdd(P.hyq + 64, 0) < nB && ++spins < 400000) __builtin_amdgcn_s_sleep(8);
        __threadfence();
      }
      __syncthreads();
      _Pragma("unroll 1") for (int t = bid - 128; t < 3328; t += nB) rglru_task<2>(P, t, smem);
      {
        int gb = 0;
        gb = cvt_run_r(P.od_w_out, 2048, 2048, P.w_out_t, smem, gb, bid - 128, nB);
        gb = cvt_run_r(P.mlp_w1 + (size_t)2048 * 8192, 2048, 8192, P.w1_t, smem, gb, bid - 128, nB);
        gb = cvt_run_r(P.mlp_w2 + (size_t)2048 * 8192, 8192, 2048, P.w2_t, smem, gb, bid - 128, nB);
      }
    }
    xcd_barrier(xb);
  } else {
    _Pragma("unroll 1") for (int t = bid; t < 3328; t += G) rglru_task<1>(P, t, smem);
    _Pragma("unroll 1") for (int t = bid; t < 128; t += G) hgrn2_block_task32(P, t, smem);
    xcd_barrier(xb);
    _Pragma("unroll 1") for (int t = bid; t < 3328; t += G) rglru_task<2>(P, t, smem);
    {
      int gb = 0;
      gb = cvt_run(P.od_w_out, 2048, 2048, P.w_out_t, smem, gb);
      gb = cvt_run(P.mlp_w1 + (size_t)2048 * 8192, 2048, 8192, P.w1_t, smem, gb);
      gb = cvt_run(P.mlp_w2 + (size_t)2048 * 8192, 8192, 2048, P.w2_t, smem, gb);
    }
    xcd_barrier(xb);
  }
  l1_readout_phase(P);
  xcd_barrier(xb);
  pg8_run(smem, P.H, P.w_out_t, MLAT, 2048, 2048, PEpiResid{P.out, P.xc, P.out, P.xc, mod1, 2, 1}, 0);
  xcd_barrier(xb);
  norm_phase(P.out, P.xc, P.norm_w + 6144, mod1, 3, P.H, MLAT, 0);
  xcd_barrier(xb);
  pg8_run(smem, P.H, P.w1_t, MLAT, 8192, 2048, PEpiBf16<ActSqRelu>{P.RP, 8192, 8192, ActSqRelu{}}, 0);
  xcd_barrier(xb);
  pg8_run(smem, P.RP, P.w2_t, MLAT, 2048, 8192, PEpiResid{P.out, P.xc, P.out, P.xc, mod1, 5, 0}, 0);
  xcd_barrier(xb);
  final_norm_phase(P.out, P.final_norm_w);
}

extern "C" void kernel_launch(void* const* d_in, const int* in_sizes, int n_in, void* d_out, int out_size,
                              void* d_ws, size_t ws_size, hipStream_t stream) {
  constexpr size_t kDynLds = 143360;
  static int grid_blocks = 0;
  if (!grid_blocks) {
    hipFuncSetAttribute((const void*)mega, hipFuncAttributeMaxDynamicSharedMemorySize, (int)kDynLds);
    int dev = 0, cus = 0, per_cu = 0;
    hipGetDevice(&dev);
    hipDeviceGetAttribute(&cus, hipDeviceAttributeMultiprocessorCount, dev);
    hipOccupancyMaxActiveBlocksPerMultiprocessor(&per_cu, mega, NT, kDynLds);
    if (per_cu < 1) per_cu = 1;
    grid_blocks = cus;
  }
  Params p{};
  const float* const* in = (const float* const*)d_in;
  p.x = in[0]; p.c = in[1]; p.ctx = in[2]; p.c_ctx = in[3]; p.ada_w = in[4]; p.ada_b = in[5]; p.norm_w = in[6];
  p.mlp_w1 = in[7]; p.mlp_w2 = in[8]; p.final_norm_w = in[9]; p.ev_w_in = in[10]; p.ev_w_out = in[11];
  p.hy_conv_w = in[12]; p.hy_conv_b = in[13]; p.hy_f_w1 = in[14]; p.hy_f_b1 = in[15]; p.hy_f_w2 = in[16]; p.hy_f_b2 = in[17];
  p.hy_f_w3 = in[18]; p.hy_freq = in[19]; p.hy_bias = in[20]; p.rw_mu = in[21]; p.rw_w0 = in[22]; p.rw_w2 = in[23];
  p.rw_a0 = in[24]; p.rw_a2 = in[25]; p.rw_g2 = in[26]; p.rw_k_k = in[27]; p.rw_k_a = in[28]; p.rw_r_k = in[29];
  p.rw_ln_w = in[30]; p.rw_ln_b = in[31]; p.od_w_in = in[32]; p.od_w_out = in[33]; p.hg_lb = in[34]; p.hg_norm_w = in[35];
  p.rg_conv_w = in[36]; p.rg_conv_b = in[37]; p.rg_wa = in[38]; p.rg_ba = in[39]; p.rg_wx = in[40]; p.rg_bx = in[41]; p.rg_lam = in[42];
  p.out = (float*)d_out;
  char* ws = (char*)d_ws;
  p.mod = (float*)(ws);
  p.tw = (float2*)(ws + 512 * 1024);
  p.half = (float2*)(ws + 640 * 1024);
  p.h2b = (bf16_t*)(ws + 1 * MiB);
  p.h2cb = (bf16_t*)(ws + 3 * MiB);
  p.tapsc = (float*)(ws + 4 * MiB);
  p.xc = (float*)(ws + 8 * MiB);
  p.bonus = (float*)(ws + 12 * MiB);
  p.w3t = (bf16_t*)(ws + 17 * MiB);
  p.g2t = (bf16_t*)(ws + 17 * MiB + 512 * 1024);
  p.rgsum = (float*)(ws + 18 * MiB);
  p.hyq = (int*)(ws + 384 * 1024);
  p.xbar = (unsigned*)(ws + 448 * 1024);
  p.w_in_t = (bf16_t*)(ws + 24 * MiB);
  p.w_out_t = (bf16_t*)(ws + 52 * MiB);
  p.w1_t = (bf16_t*)(ws + 60 * MiB);
  p.w2_t = (bf16_t*)(ws + 92 * MiB);
  p.H = (bf16_t*)(ws + 124 * MiB);
  p.RP = (bf16_t*)(ws + 254 * MiB);
  p.RA = (bf16_t*)(ws + 709 * MiB);
  void* args[] = {&p};
  hipError_t e = hipLaunchCooperativeKernel((void*)mega, dim3(grid_blocks), dim3(NT), args, kDynLds, stream);
  if (e != hipSuccess) fprintf(stderr, "coop launch failed: %s\n", hipGetErrorString(e));
}
```

```cpp
#include <hip/hip_runtime.h>
#include <hip/hip_cooperative_groups.h>
#include <cstdio>
namespace cg = cooperative_groups;

typedef unsigned short bf16_t;
typedef short bf16x8 __attribute__((ext_vector_type(8)));
typedef float f32x4 __attribute__((ext_vector_type(4)));

#define NT 512
#define MLAT 32768
#define MALL 33280
#define LSEQ 16384
#define MiB (1048576ull)

struct Params {
  const float *x, *c, *ctx, *c_ctx, *ada_w, *ada_b, *norm_w, *mlp_w1, *mlp_w2, *final_norm_w;
  const float *ev_w_in, *ev_w_out, *hy_conv_w, *hy_conv_b, *hy_f_w1, *hy_f_b1, *hy_f_w2, *hy_f_b2, *hy_f_w3, *hy_freq, *hy_bias;
  const float *rw_mu, *rw_w0, *rw_w2, *rw_a0, *rw_a2, *rw_g2, *rw_k_k, *rw_k_a, *rw_r_k, *rw_ln_w, *rw_ln_b;
  const float *od_w_in, *od_w_out, *hg_lb, *hg_norm_w, *rg_conv_w, *rg_conv_b, *rg_wa, *rg_ba, *rg_wx, *rg_bx, *rg_lam;
  float* out;
  float* mod; float2* tw; float2* half; bf16_t* h2b; bf16_t* h2cb; float* tapsc; float* xc; float* bonus; bf16_t* w3t; bf16_t* g2t; float* rgsum; int* hyq; unsigned* xbar;
  bf16_t *w_in_t, *w_out_t, *w1_t, *w2_t;
  bf16_t* H;
  bf16_t* RP;
  bf16_t* RA;
};

__device__ __forceinline__ int tid_() { int t = threadIdx.x; asm volatile("" : "+v"(t)); return t; }
__device__ __forceinline__ float bf2f(bf16_t v) { return __uint_as_float(((unsigned)v) << 16); }
__device__ __forceinline__ unsigned pack2(float a, float b) { unsigned r; asm("v_cvt_pk_bf16_f32 %0, %1, %2" : "=v"(r) : "v"(a), "v"(b)); return r; }
__device__ __forceinline__ bf16_t f2bf(float f) { return (bf16_t)(pack2(f, f) & 0xffffu); }
__device__ __forceinline__ float sigmoidf_(float x) { return 1.f / (1.f + expf(-x)); }
__device__ __forceinline__ float siluf_(float x) { return x / (1.f + expf(-x)); }
__device__ __forceinline__ float fsig(float x) { return __builtin_amdgcn_rcpf(1.f + __expf(-x)); }
__device__ __forceinline__ float gelu_tanh_(float x) { return 0.5f * x * (1.f + tanhf(0.7978845608f * (x + 0.044715f * x * x * x))); }
__device__ __forceinline__ float2 cmul(float2 a, float2 b) { return make_float2(a.x * b.x - a.y * b.y, a.x * b.y + a.y * b.x); }
__device__ __forceinline__ float2 cmulc(float2 a, float2 b) { return make_float2(a.x * b.x + a.y * b.y, a.y * b.x - a.x * b.y); }
__device__ __forceinline__ void unpack8(bf16x8 v, float* o) {
#pragma unroll
  for (int j = 0; j < 8; ++j) o[j] = bf2f((bf16_t)v[j]);
}
__device__ __forceinline__ void row_info(int row, int& pos, int& len) {
  if (row < MLAT) { pos = row & (LSEQ - 1); len = LSEQ; } else { pos = (row - MLAT) & 255; len = 256; }
}
__device__ __forceinline__ int step_row(int s, int b, int dir, int& pos, int& len) {
  if (s < 256) { len = 256; pos = dir ? 255 - s : s; return MLAT + b * 256 + pos; }
  len = LSEQ; int ls = s - 256; pos = dir ? LSEQ - 1 - ls : ls; return b * LSEQ + pos;
}
__device__ __forceinline__ float wave_sum(float v) {
#pragma unroll
  for (int m = 32; m >= 1; m >>= 1) v += __shfl_xor(v, m);
  return v;
}
__device__ __forceinline__ float block_sum(float v, float* red) {
  v = wave_sum(v);
  __syncthreads();
  if ((tid_() & 63) == 0) red[tid_() >> 6] = v;
  __syncthreads();
  float s = 0.f;
#pragma unroll
  for (int i = 0; i < 8; ++i) s += red[i];
  __syncthreads();
  return s;
}

__device__ __forceinline__ void rw_shift8(const bf16_t* __restrict__ prw, const float* __restrict__ mu, int row, int pos, int len, int c, float* o) {
  const bf16_t* p = prw + (size_t)row * 3712 + c;
  bf16x8 cur = *(const bf16x8*)p;
  bf16x8 z = {0, 0, 0, 0, 0, 0, 0, 0};
  bf16x8 prv = pos > 0 ? *(const bf16x8*)(p - 3712) : z;
  bf16x8 nxt = pos < len - 1 ? *(const bf16x8*)(p + 3712) : z;
  float4 m0 = *(const float4*)(mu + c), m1 = *(const float4*)(mu + c + 4);
  float mm[8] = {m0.x, m0.y, m0.z, m0.w, m1.x, m1.y, m1.z, m1.w};
#pragma unroll
  for (int j = 0; j < 8; ++j) {
    float cc = bf2f((bf16_t)cur[j]), pp = bf2f((bf16_t)prv[j]), nn = bf2f((bf16_t)nxt[j]);
    o[j] = cc + (0.5f * (pp + nn) - cc) * mm[j];
  }
}

struct ALoadPlain {
  const bf16_t* A; size_t lda;
  __device__ __forceinline__ bf16x8 operator()(int row, int k) const { return *(const bf16x8*)(A + (size_t)row * lda + k); }
};
struct ALoadG {
  const bf16_t* prw; const float* mu;
  __device__ __forceinline__ bf16x8 operator()(int row, int k) const {
    int pos, len; row_info(row, pos, len);
    float v[8]; rw_shift8(prw, mu, row, pos, len, 3456 + k, v);
    bf16x8 r;
#pragma unroll
    for (int j = 0; j < 8; ++j) r[j] = (short)f2bf(sigmoidf_(v[j]));
    return r;
  }
};

template <bool TRANS, class AL, class EP>
__device__ __forceinline__ void gemm_tile(const AL& al, const bf16_t* __restrict__ Bt, int K, int row0, int col0, const EP& ep, char* smem) {
  constexpr int LDT = 72;
  bf16_t* sA0 = (bf16_t*)smem;
  bf16_t* sB0 = sA0 + 256 * LDT;
  bf16_t* sA1 = (bf16_t*)(smem + 55296);
  bf16_t* sB1 = sA1 + 256 * LDT;
  const int tid = tid_(), wave = tid >> 6, lane = tid & 63, wm = wave >> 1, wn = wave & 1, fr = lane & 15, fq = lane >> 4;
  const int lr = tid >> 3, lk = (tid & 7) * 8;
  f32x4 acc[4][4];
#pragma unroll
  for (int i = 0; i < 4; ++i)
#pragma unroll
    for (int j = 0; j < 4; ++j) acc[i][j] = (f32x4){0.f, 0.f, 0.f, 0.f};
  bf16x8 ra[4], rb[2];
  const int nk = K >> 6;
#pragma unroll
  for (int i = 0; i < 4; ++i) ra[i] = al(row0 + lr + 64 * i, lk);
#pragma unroll
  for (int i = 0; i < 2; ++i) rb[i] = *(const bf16x8*)(Bt + (size_t)(col0 + lr + 64 * i) * K + lk);
#pragma unroll
  for (int i = 0; i < 4; ++i) *(bf16x8*)(sA0 + (lr + 64 * i) * LDT + lk) = ra[i];
#pragma unroll
  for (int i = 0; i < 2; ++i) *(bf16x8*)(sB0 + (lr + 64 * i) * LDT + lk) = rb[i];
  __syncthreads();
  for (int kt = 0; kt < nk; ++kt) {
    const bool more = kt + 1 < nk;
    if (more) {
      const int k0 = (kt + 1) * 64 + lk;
#pragma unroll
      for (int i = 0; i < 4; ++i) ra[i] = al(row0 + lr + 64 * i, k0);
#pragma unroll
      for (int i = 0; i < 2; ++i) rb[i] = *(const bf16x8*)(Bt + (size_t)(col0 + lr + 64 * i) * K + k0);
    }
    const bf16_t* cA = (kt & 1) ? sA1 : sA0;
    const bf16_t* cB = (kt & 1) ? sB1 : sB0;
#pragma unroll
    for (int ks = 0; ks < 2; ++ks) {
      bf16x8 af[4], bfr[4];
#pragma unroll
      for (int mi = 0; mi < 4; ++mi) af[mi] = *(const bf16x8*)(cA + (wm * 64 + mi * 16 + fr) * LDT + ks * 32 + fq * 8);
#pragma unroll
      for (int ni = 0; ni < 4; ++ni) bfr[ni] = *(const bf16x8*)(cB + (wn * 64 + ni * 16 + fr) * LDT + ks * 32 + fq * 8);
#pragma unroll
      for (int mi = 0; mi < 4; ++mi)
#pragma unroll
        for (int ni = 0; ni < 4; ++ni) {
          if (TRANS) acc[mi][ni] = __builtin_amdgcn_mfma_f32_16x16x32_bf16(af[mi], bfr[ni], acc[mi][ni], 0, 0, 0);
          else acc[mi][ni] = __builtin_amdgcn_mfma_f32_16x16x32_bf16(bfr[ni], af[mi], acc[mi][ni], 0, 0, 0);
        }
    }
    if (more) {
      bf16_t* nA = (kt & 1) ? sA0 : sA1;
      bf16_t* nB = (kt & 1) ? sB0 : sB1;
#pragma unroll
      for (int i = 0; i < 4; ++i) *(bf16x8*)(nA + (lr + 64 * i) * LDT + lk) = ra[i];
#pragma unroll
      for (int i = 0; i < 2; ++i) *(bf16x8*)(nB + (lr + 64 * i) * LDT + lk) = rb[i];
    }
    __syncthreads();
  }
#pragma unroll
  for (int mi = 0; mi < 4; ++mi)
#pragma unroll
    for (int ni = 0; ni < 4; ++ni) {
      if (TRANS) ep(row0 + wm * 64 + mi * 16 + fq * 4, col0 + wn * 64 + ni * 16 + fr, acc[mi][ni]);
      else ep(row0 + wm * 64 + mi * 16 + fr, col0 + wn * 64 + ni * 16 + fq * 4, acc[mi][ni]);
    }
}

template <bool TRANS, class AL, class EP>
__device__ __forceinline__ int gemm_run(const AL& al, const bf16_t* Bt, int K, int M, int N, const EP& ep, char* smem, int gbase) {
  const int nM = M >> 8, nN = N >> 7, nt = nM * nN, G = gridDim.x;
  const int g0 = gbase + ((((int)blockIdx.x - gbase) % G) + G) % G;
  const int nig = 8 * nN;
  for (int g = g0; g < gbase + nt; g += G) {
    const int tile = g - gbase;
    const int gid = tile / nig, fm = gid * 8, gsz = min(8, nM - fm);
    const int pm = fm + (tile % nig) % gsz, pn = (tile % nig) / gsz;
    gemm_tile<TRANS>(al, Bt, K, pm * 256, pn * 128, ep, smem);
  }
  return gbase + nt;
}

struct EpTransBf16 {
  bf16_t* dst; size_t ld;
  __device__ __forceinline__ void operator()(int row, int col, f32x4 v) const {
    uint2 u; u.x = pack2(v[0], v[1]); u.y = pack2(v[2], v[3]);
    *(uint2*)(dst + (size_t)col * ld + row) = u;
  }
};
struct EpTransF32 {
  float* dst; size_t ld;
  __device__ __forceinline__ void operator()(int row, int col, f32x4 v) const { *(f32x4*)(dst + (size_t)col * ld + row) = v; }
};
struct EpBf16 {
  bf16_t* dst; size_t ld;
  __device__ __forceinline__ void operator()(int row, int col, f32x4 v) const {
    uint2 u; u.x = pack2(v[0], v[1]); u.y = pack2(v[2], v[3]);
    *(uint2*)(dst + (size_t)row * ld + col) = u;
  }
};
struct EpSqRelu {
  bf16_t* dst; size_t ld;
  __device__ __forceinline__ void operator()(int row, int col, f32x4 v) const {
    float a = fmaxf(v[0], 0.f), b = fmaxf(v[1], 0.f), c = fmaxf(v[2], 0.f), d = fmaxf(v[3], 0.f);
    uint2 u; u.x = pack2(a * a, b * b); u.y = pack2(c * c, d * d);
    *(uint2*)(dst + (size_t)row * ld + col) = u;
  }
};
struct EpResid {
  const float* src_lat; const float* src_ctx; float* dst_lat; float* dst_ctx; const float* modl; int chunk; int unperm;
  __device__ __forceinline__ void operator()(int row, int col, f32x4 v) const {
    const float* s; float* d; int which;
    if (row < MLAT) {
      int r = row; which = row >> 14;
      if (unperm) { int tp = row & (LSEQ - 1); r = (row & ~(LSEQ - 1)) + (tp & 255) * 64 + (tp >> 8); }
      s = src_lat + (size_t)r * 2048 + col; d = dst_lat + (size_t)r * 2048 + col;
    } else { which = 2; s = src_ctx + (size_t)(row - MLAT) * 2048 + col; d = dst_ctx + (size_t)(row - MLAT) * 2048 + col; }
    f32x4 g = *(const f32x4*)(modl + which * 12288 + chunk * 2048 + col);
    f32x4 x = *(const f32x4*)s;
    *(f32x4*)d = x + g * v;
  }
};
struct EpIn1 {
  bf16_t* dst; const float* hg_lb;
  __device__ __forceinline__ void operator()(int row, int col, f32x4 v) const {
    float o[4];
    if (col < 1024 || (col >= 4096 && col < 5120)) {
#pragma unroll
      for (int j = 0; j < 4; ++j) o[j] = siluf_(v[j]);
    } else if (col < 3072) {
#pragma unroll
      for (int j = 0; j < 4; ++j) {
        int i = col - 1024 + j;
        float lb = 1.f / (1.f + expf(hg_lb[i] - hg_lb[2048 + i]));
        o[j] = (1.f - lb) / (1.f + expf(v[j]));
      }
    } else if (col >= 6144) {
#pragma unroll
      for (int j = 0; j < 4; ++j) o[j] = gelu_tanh_(v[j]);
    } else {
#pragma unroll
      for (int j = 0; j < 4; ++j) o[j] = v[j];
    }
    uint2 u; u.x = pack2(o[0], o[1]); u.y = pack2(o[2], o[3]);
    *(uint2*)(dst + (size_t)row * 7168 + col) = u;
  }
};

namespace pg8 {
#define PG8_LAS __attribute__((address_space(3)))
typedef unsigned short bf16_t;
typedef short bf16x8 __attribute__((ext_vector_type(8)));
typedef float f32x4 __attribute__((ext_vector_type(4)));
typedef unsigned u32x4 __attribute__((ext_vector_type(4)));
constexpr int BM = 256, BK = 64, HALF = 128, HTB = HALF * BK * 2  , STAGE_BYTES = 8 * HTB, NXCD = 8, WGM = 8;

__host__ __device__ __forceinline__ int lds_byte(int r, int c) { const int st = (r >> 4) * 2 + (c >> 5), rr = r & 15, cc = c & 31, ob = rr * 64 + cc * 2; return st * 1024 + (ob ^ (((ob >> 9) & 1) << 5)); }
__host__ __device__ __forceinline__ void stage_rc(int b, int& R, int& C) { const int st = b / 1024, sb = b % 1024, swz = sb ^ (((sb >> 9) & 1) << 5); R = (st >> 1) * 16 + swz / 64; C = (st & 1) * 32 + (swz % 64) / 2; }
__host__ __device__ __forceinline__ int perm32(int rho) { const int n = rho >> 4, i = rho & 15; return 8 * (i >> 2) + 4 * n + (i & 3); }

struct Unit { int pm, pn; };
struct Gemm { const bf16_t* A; const bf16_t* Bt; int M, N, K, ld; };

struct StaticOrder {
    int nM, nN, nwg, G, c;
    __host__ __device__ void init(int M, int N, int G_, int c_) { nM = M / BM; nN = N / BM; nwg = nM * nN; G = G_; c = c_; }
    __host__ __device__ bool next(int i, Unit& u) const {
        const long L = (long)i * G + c; if (L >= nwg) return false;
        int wgid = (int)L; { const int q = nwg / NXCD, r = nwg % NXCD, xcd = wgid % NXCD, off = wgid / NXCD; wgid = (xcd < r ? xcd * (q + 1) : r * (q + 1) + (xcd - r) * q) + off; }
        const int nig = WGM * nN, gid = wgid / nig, fm = gid * WGM, gsz = (nM - fm) < WGM ? (nM - fm) : WGM;
        u.pm = fm + ((wgid % nig) % gsz); u.pn = (wgid % nig) / gsz; return true;
    }
    __device__ __forceinline__ void a_ready(const Unit&) const {}
    __device__ __forceinline__ void done(const Unit&) const {}
};
__device__ __forceinline__ unsigned cvt_pk_bf16(float lo, float hi) { unsigned r; asm volatile("v_cvt_pk_bf16_f32 %0, %1, %2" : "=v"(r) : "v"(lo), "v"(hi)); return r; }
template <class Epi, class Sched, bool STAMP = false>
__device__ __forceinline__ void gemm_phase(PG8_LAS unsigned char* lds, const Gemm g, const Sched& S, const Epi& E, unsigned long long* stamps) {
    const int tid = threadIdx.x, wid = __builtin_amdgcn_readfirstlane(tid >> 6), lane = tid & 63, wr = wid >> 2, wc = wid & 3, fr = lane & 15, fq = lane >> 4;
    const int K = g.ld, nt = g.K / BK;
    int ts_lo = 0, ts_hi = 0, nts = 0; const unsigned long long rt_entry = STAMP ? (unsigned long long)wall_clock64() : 0ull;
#define PG8_STAMP() do { if (STAMP && wid == 0 && nts < 64) { const unsigned long long _c = (unsigned long long)clock64(); \
        ts_lo = (lane == nts) ? (int)(unsigned)_c : ts_lo; ts_hi = (lane == nts) ? (int)(unsigned)(_c >> 32) : ts_hi; ++nts; } } while (0)
    PG8_STAMP();
    unsigned voffA[2], voffB[2];
#pragma unroll
    for (int i = 0; i < 2; ++i) { int R, C; stage_rc(tid * 16 + i * 8192, R, C); const int Rb = Epi::PERM ? ((R & ~31) + perm32(R & 31)) : R;
        voffA[i] = (unsigned)(R * K + C) * 2u; voffB[i] = (unsigned)(Rb * K + C) * 2u; }
    const size_t kstep = (size_t)(BK * 2);
    const size_t hstep = (size_t)HALF * K * 2;
    const size_t tstep = 2 * hstep;
    const unsigned ldsw = (unsigned)wid * 1024u;
    const int aoff = lds_byte(wr * 64 + fr, fq * 8), boff = lds_byte(wc * 32 + fr, fq * 8);
#define PG8_SA(b, h) (((b) * 2 + (h)) * HTB)
#define PG8_SB(b, h) ((4 + (b) * 2 + (h)) * HTB)
#define PG8_STAGE(bufoff, gbase, voff) do { _Pragma("unroll") for (int _i = 0; _i < 2; ++_i) \
        __builtin_amdgcn_global_load_lds((const unsigned*)((const char*)(gbase) + (voff)[_i]), (PG8_LAS unsigned*)(lds + (bufoff) + ldsw + _i * 8192), 16, 0, 0); } while (0)
#define PG8_LDA(dst, b, h) do { _Pragma("unroll") for (int m = 0; m < 4; ++m) _Pragma("unroll") for (int k = 0; k < 2; ++k) dst[m][k] = *(const PG8_LAS bf16x8*)(lds + PG8_SA(b, h) + aoff + m * 2048 + k * 1024); } while (0)
#define PG8_LDB(dst, b, h) do { _Pragma("unroll") for (int n = 0; n < 2; ++n) _Pragma("unroll") for (int k = 0; k < 2; ++k) dst[n][k] = *(const PG8_LAS bf16x8*)(lds + PG8_SB(b, h) + boff + n * 2048 + k * 1024); } while (0)
#define PG8_MMA(ai, bj, At, Bt) do { __builtin_amdgcn_s_setprio(1); _Pragma("unroll") for (int m = 0; m < 4; ++m) _Pragma("unroll") for (int n = 0; n < 2; ++n) _Pragma("unroll") for (int k = 0; k < 2; ++k) \
        acc[ai][bj][m][n] = __builtin_amdgcn_mfma_f32_16x16x32_bf16(Bt[n][k], At[m][k], acc[ai][bj][m][n], 0, 0, 0); __builtin_amdgcn_s_setprio(0); } while (0)
#define PG8_WAIT_V(n) asm volatile("s_waitcnt vmcnt(" #n ")" ::: "memory")
#define PG8_WAIT_L(n) asm volatile("s_waitcnt lgkmcnt(" #n ")" ::: "memory")
#define PG8_BAR __builtin_amdgcn_s_barrier()
#define PG8_SCHED __builtin_amdgcn_sched_barrier(0)
    Unit cur, nxt; int ui = 0;
    if (!S.next(0, cur)) return;
    f32x4 acc[2][2][4][2];
#pragma unroll
    for (int a = 0; a < 2; ++a)
#pragma unroll
        for (int b = 0; b < 2; ++b)
#pragma unroll
            for (int m = 0; m < 4; ++m)
#pragma unroll
                for (int n = 0; n < 2; ++n) acc[a][b][m][n] = (f32x4){0.f, 0.f, 0.f, 0.f};
    bf16x8 At[4][2], B0[2][2], B1[2][2];
    const char* cA = (const char*)g.A + (size_t)cur.pm * tstep; const char* cB = (const char*)g.Bt + (size_t)cur.pn * tstep;
    S.a_ready(cur);
    PG8_STAGE(PG8_SB(0, 0), cB, voffB); PG8_STAGE(PG8_SA(0, 0), cA, voffA); PG8_STAGE(PG8_SB(0, 1), cB + hstep, voffB); PG8_STAGE(PG8_SA(0, 1), cA + hstep, voffA);
    if (wr == 1) PG8_BAR;
    PG8_WAIT_V(4); PG8_BAR;
    PG8_STAGE(PG8_SB(1, 0), cB + kstep, voffB); PG8_STAGE(PG8_SA(1, 0), cA + kstep, voffA); PG8_STAGE(PG8_SB(1, 1), cB + hstep + kstep, voffB);
    PG8_WAIT_V(6); PG8_BAR;
    PG8_STAMP();
    for (;;) {
        const bool has_next = S.next(ui + 1, nxt);
        const char* nA = has_next ? (const char*)g.A + (size_t)nxt.pm * tstep : cA; const char* nB = has_next ? (const char*)g.Bt + (size_t)nxt.pn * tstep : cB;
        for (int t = 0; t < nt; t += 2) {
            const bool last = (t == nt - 2);
            const char* a1 = cA + (size_t)(t + 1) * kstep;
            const char* a2 = last ? nA : cA + (size_t)(t + 2) * kstep; const char* b2 = last ? nB : cB + (size_t)(t + 2) * kstep;
            const char* a3 = a2 + kstep; const char* b3 = b2 + kstep;
            if (last && has_next) S.a_ready(nxt);
            PG8_LDB(B0, 0, 0); PG8_SCHED; PG8_LDA(At, 0, 0); PG8_STAGE(PG8_SA(1, 1), a1 + hstep, voffA);
            PG8_WAIT_L(8); PG8_BAR; PG8_WAIT_L(0); PG8_MMA(0, 0, At, B0); PG8_BAR; PG8_SCHED;
            PG8_LDB(B1, 0, 1); PG8_STAGE(PG8_SB(0, 0), b2, voffB);
            PG8_BAR; PG8_WAIT_L(0); PG8_MMA(0, 1, At, B1); PG8_BAR;
            PG8_LDA(At, 0, 1); PG8_STAGE(PG8_SA(0, 0), a2, voffA);
            PG8_BAR; PG8_WAIT_L(0); PG8_MMA(1, 0, At, B0); PG8_BAR; PG8_SCHED;
            PG8_STAGE(PG8_SB(0, 1), b2 + hstep, voffB);
            PG8_WAIT_V(6); PG8_BAR; PG8_MMA(1, 1, At, B1); PG8_BAR;
            PG8_LDB(B0, 1, 0); PG8_SCHED; PG8_LDA(At, 1, 0); PG8_STAGE(PG8_SA(0, 1), a2 + hstep, voffA);
            PG8_WAIT_L(8); PG8_BAR; PG8_WAIT_L(0); PG8_MMA(0, 0, At, B0); PG8_BAR; PG8_SCHED;
            PG8_LDB(B1, 1, 1); PG8_STAGE(PG8_SB(1, 0), b3, voffB);
            PG8_BAR; PG8_WAIT_L(0); PG8_MMA(0, 1, At, B1); PG8_BAR;
            PG8_LDA(At, 1, 1); PG8_STAGE(PG8_SA(1, 0), a3, voffA);
            PG8_BAR; PG8_WAIT_L(0); PG8_MMA(1, 0, At, B0); PG8_BAR; PG8_SCHED;
            PG8_STAGE(PG8_SB(1, 1), b3 + hstep, voffB);
            PG8_WAIT_V(6); PG8_BAR; PG8_MMA(1, 1, At, B1); PG8_BAR;
        }
        PG8_STAMP();
        if constexpr (!Epi::AFTER_DRAIN) { E(acc, cur, wr, wc, fr, fq); S.done(cur); }
        PG8_STAMP();
        if (!has_next) break;
#pragma unroll
        for (int a = 0; a < 2; ++a)
#pragma unroll
            for (int b = 0; b < 2; ++b)
#pragma unroll
                for (int m = 0; m < 4; ++m)
#pragma unroll
                    for (int n = 0; n < 2; ++n) acc[a][b][m][n] = (f32x4){0.f, 0.f, 0.f, 0.f};
        cur = nxt; cA = nA; cB = nB; ++ui;
    }
    PG8_WAIT_V(0);
    if (wr == 0) PG8_BAR;
    PG8_BAR;
    if constexpr (Epi::AFTER_DRAIN) { E.fused(acc, cur, wr, wc, fr, fq, lds, wid, lane); S.done(cur); }
    PG8_STAMP();
    if (STAMP && wid == 0) { stamps[lane] = lane < nts ? (((unsigned long long)(unsigned)ts_hi << 32) | (unsigned)ts_lo) : 0ull;
        if (lane == 62) stamps[62] = rt_entry; if (lane == 63) stamps[63] = (unsigned long long)wall_clock64(); }
#undef PG8_STAMP
#undef PG8_SA
#undef PG8_SB
#undef PG8_STAGE
#undef PG8_LDA
#undef PG8_LDB
#undef PG8_MMA
#undef PG8_WAIT_V
#undef PG8_WAIT_L
#undef PG8_BAR
#undef PG8_SCHED
}
}

struct ActNone { __device__ __forceinline__ void operator()(int, f32x4&, f32x4&) const {} };
struct ActSqRelu { __device__ __forceinline__ void operator()(int, f32x4& a, f32x4& b) const {
#pragma unroll
  for (int j = 0; j < 4; ++j) { float x = fmaxf(a[j], 0.f), y = fmaxf(b[j], 0.f); a[j] = x * x; b[j] = y * y; } } };
struct ActIn1 { const float* hg_lb;
  __device__ __forceinline__ void operator()(int col, f32x4& a, f32x4& b) const {
    if (col < 1024 || (col >= 4096 && col < 5120)) {
#pragma unroll
      for (int j = 0; j < 4; ++j) { a[j] = a[j] * fsig(a[j]); b[j] = b[j] * fsig(b[j]); }
    } else if (col < 3072) {
#pragma unroll
      for (int j = 0; j < 4; ++j) {
        int i = col - 1024 + j;
        float lb0 = fsig(hg_lb[2048 + i] - hg_lb[i]), lb1 = fsig(hg_lb[2048 + i + 4] - hg_lb[i + 4]);
        a[j] = (1.f - lb0) * fsig(-a[j]); b[j] = (1.f - lb1) * fsig(-b[j]);
      }
    } else if (col >= 6144) {
#pragma unroll
      for (int j = 0; j < 4; ++j) {
        float ua = 1.5957691216f * (a[j] + 0.044715f * a[j] * a[j] * a[j]), ub = 1.5957691216f * (b[j] + 0.044715f * b[j] * b[j] * b[j]);
        a[j] = a[j] * fsig(ua); b[j] = b[j] * fsig(ub);
      }
    }
  } };
template <class ACT> struct PEpiBf16 {
  static constexpr bool PERM = true, AFTER_DRAIN = false;
  bf16_t* O; size_t ldc; int ncols; ACT act;
  __device__ __forceinline__ void operator()(const f32x4 (&acc)[2][2][4][2], const pg8::Unit& u, int wr, int wc, int fr, int fq) const {
    const int row0 = u.pm * 256 + wr * 64 + fr, col0 = u.pn * 256 + wc * 32 + 8 * fq;
#pragma unroll
    for (int ai = 0; ai < 2; ++ai)
#pragma unroll
      for (int m = 0; m < 4; ++m) {
        bf16_t* rowp = O + (size_t)(row0 + ai * 128 + m * 16) * ldc + col0;
#pragma unroll
        for (int bj = 0; bj < 2; ++bj) {
          const int c = col0 + bj * 128;
          if (c < ncols) {
            f32x4 v0 = acc[ai][bj][m][0], v1 = acc[ai][bj][m][1];
            act(c, v0, v1);
            pg8::u32x4 w; w.x = pack2(v0[0], v0[1]); w.y = pack2(v0[2], v0[3]); w.z = pack2(v1[0], v1[1]); w.w = pack2(v1[2], v1[3]);
            *(pg8::u32x4*)(rowp + bj * 128) = w;
          }
        }
      }
  }
};
struct PEpiResid {
  static constexpr bool PERM = false, AFTER_DRAIN = false;
  const float* src_lat; const float* src_ctx; float* dst_lat; float* dst_ctx; const float* modl; int chunk; int unperm;
  __device__ __forceinline__ void operator()(const f32x4 (&acc)[2][2][4][2], const pg8::Unit& u, int wr, int wc, int fr, int fq) const {
    const int row0 = u.pm * 256 + wr * 64 + fr, col0 = u.pn * 256 + wc * 32 + 4 * fq;
#pragma unroll
    for (int ai = 0; ai < 2; ++ai)
#pragma unroll
      for (int m = 0; m < 4; ++m) {
        const int row = row0 + ai * 128 + m * 16;
        const float* s; float* d; int which;
        if (row < MLAT) {
          int r = row; which = row >> 14;
          if (unperm) { int tp = row & (LSEQ - 1); r = (row & ~(LSEQ - 1)) + (tp & 255) * 64 + (tp >> 8); }
          s = src_lat + (size_t)r * 2048; d = dst_lat + (size_t)r * 2048;
        } else { which = 2; s = src_ctx + (size_t)(row - MLAT) * 2048; d = dst_ctx + (size_t)(row - MLAT) * 2048; }
        const float* gp = modl + which * 12288 + chunk * 2048;
#pragma unroll
        for (int bj = 0; bj < 2; ++bj)
#pragma unroll
          for (int n = 0; n < 2; ++n) {
            const int col = col0 + bj * 128 + n * 16;
            f32x4 g = *(const f32x4*)(gp + col), x = *(const f32x4*)(s + col);
            *(f32x4*)(d + col) = x + g * acc[ai][bj][m][n];
          }
      }
  }
};
template <class Epi>
__device__ __forceinline__ int pg8_run(char* smem, const bf16_t* A, const bf16_t* Bt, int M, int N, int K, const Epi& E, int rot) {
  pg8::StaticOrder S; S.init(M, N, (int)gridDim.x, (int)((blockIdx.x + gridDim.x - rot) % gridDim.x));
  pg8::gemm_phase<Epi, pg8::StaticOrder, false>((PG8_LAS unsigned char*)smem, pg8::Gemm{A, Bt, M, N, K, K}, S, E, nullptr);
  return (rot + (M / 256) * (N / 256)) % (int)gridDim.x;
}


struct PEpiPartial {
  static constexpr bool PERM = false, AFTER_DRAIN = false;
  float* part;
  __device__ __forceinline__ void operator()(const f32x4 (&acc)[2][2][4][2], const pg8::Unit& u, int wr, int wc, int fr, int fq) const {
    const int row0 = u.pm * 256 + wr * 64 + fr, col0 = u.pn * 256 + wc * 32 + 4 * fq;
#pragma unroll
    for (int ai = 0; ai < 2; ++ai)
#pragma unroll
      for (int m = 0; m < 4; ++m) {
        float* d = part + (size_t)(row0 + ai * 128 + m * 16) * 2048 + col0;
#pragma unroll
        for (int bj = 0; bj < 2; ++bj)
#pragma unroll
          for (int n = 0; n < 2; ++n) *(f32x4*)(d + bj * 128 + n * 16) = acc[ai][bj][m][n];
      }
  }
};
__device__ __forceinline__ void pg8_ctx_splitk(char* smem, const bf16_t* A, const bf16_t* Bt, int K, float* part, int rot0) {
  const int Ks = K / 8, G = (int)gridDim.x;
#pragma unroll 1
  for (int ks = 0; ks < 8; ++ks) {
    pg8::StaticOrder S; S.init(512, 2048, G, (int)(((int)blockIdx.x + 64 * G - rot0 - 16 * ks) % G));
    pg8::gemm_phase<PEpiPartial, pg8::StaticOrder, false>((PG8_LAS unsigned char*)smem, pg8::Gemm{A + ks * Ks, Bt + ks * Ks, 512, 2048, Ks, K}, S, PEpiPartial{part + (size_t)ks * 512 * 2048}, nullptr);
  }
}

__device__ __forceinline__ void adaln_task(const Params& P, char* smem, int task) {
  float* s = (float*)smem;
  float* red = s + 3 * 2048;
  const int tid = tid_(), l = task / 96, cgp = task % 96;
  for (int i = tid; i < 3 * 2048; i += NT) {
    int w = i >> 11, k = i & 2047;
    float v = (w < 2) ? P.c[w * 2048 + k] : P.c_ctx[k];
    s[i] = siluf_(v);
  }
  __syncthreads();
  const int c4 = tid & 31, ks = tid >> 5;
  const float* W = P.ada_w + (size_t)l * 2048 * 12288 + cgp * 128 + c4 * 4;
  float a0[4] = {0, 0, 0, 0}, a1[4] = {0, 0, 0, 0}, a2[4] = {0, 0, 0, 0};
  for (int k = ks * 128; k < ks * 128 + 128; ++k) {
    float4 w = *(const float4*)(W + (size_t)k * 12288);
    float s0 = s[k], s1 = s[2048 + k], s2 = s[4096 + k];
    a0[0] += s0 * w.x; a0[1] += s0 * w.y; a0[2] += s0 * w.z; a0[3] += s0 * w.w;
    a1[0] += s1 * w.x; a1[1] += s1 * w.y; a1[2] += s1 * w.z; a1[3] += s1 * w.w;
    a2[0] += s2 * w.x; a2[1] += s2 * w.y; a2[2] += s2 * w.z; a2[3] += s2 * w.w;
  }
#pragma unroll
  for (int j = 0; j < 4; ++j) {
    red[(ks * 3 + 0) * 128 + c4 * 4 + j] = a0[j];
    red[(ks * 3 + 1) * 128 + c4 * 4 + j] = a1[j];
    red[(ks * 3 + 2) * 128 + c4 * 4 + j] = a2[j];
  }
  __syncthreads();
  if (tid < 384) {
    int w = tid >> 7, cc = tid & 127;
    float sum = 0.f;
    for (int k = 0; k < 16; ++k) sum += red[(k * 3 + w) * 128 + cc];
    int col = cgp * 128 + cc;
    P.mod[(size_t)(l * 3 + w) * 12288 + col] = sum + P.ada_b[l * 12288 + col];
  }
  __syncthreads();
}

__device__ __forceinline__ void cvt_tile(const float* __restrict__ src, int K, int N, bf16_t* __restrict__ dst, int tile, char* smem) {
  float* t = (float*)smem;
  const int tid = tid_(), nT = N >> 7, kt = tile / nT, nt = tile % nT;
  float4 v[4];
#pragma unroll
  for (int i = 0; i < 4; ++i) {
    int r = (tid >> 5) + 16 * i, c4 = (tid & 31) * 4;
    v[i] = *(const float4*)(src + (size_t)(kt * 64 + r) * N + nt * 128 + c4);
  }
#pragma unroll
  for (int i = 0; i < 4; ++i) {
    int r = (tid >> 5) + 16 * i, c4 = (tid & 31) * 4;
    t[r * 129 + c4] = v[i].x; t[r * 129 + c4 + 1] = v[i].y; t[r * 129 + c4 + 2] = v[i].z; t[r * 129 + c4 + 3] = v[i].w;
  }
  __syncthreads();
#pragma unroll
  for (int i = 0; i < 2; ++i) {
    int n = (tid >> 3) + 64 * i, k8 = (tid & 7) * 8;
    bf16x8 o;
#pragma unroll
    for (int j = 0; j < 8; ++j) o[j] = (short)f2bf(t[(k8 + j) * 129 + n]);
    *(bf16x8*)(dst + (size_t)(nt * 128 + n) * K + kt * 64 + k8) = o;
  }
  __syncthreads();
}
__device__ __forceinline__ int cvt_run_r(const float* src, int K, int N, bf16_t* dst, char* smem, int gbase, int rank, int nranks) {
  const int nt = (K >> 6) * (N >> 7);
  const int g0 = gbase + (((rank - gbase) % nranks) + nranks) % nranks;
  for (int g = g0; g < gbase + nt; g += nranks) cvt_tile(src, K, N, dst, g - gbase, smem);
  return gbase + nt;
}
__device__ __forceinline__ int cvt_run(const float* src, int K, int N, bf16_t* dst, char* smem, int gbase) {
  const int nt = (K >> 6) * (N >> 7), G = gridDim.x;
  const int g0 = gbase + ((((int)blockIdx.x - gbase) % G) + G) % G;
  for (int g = g0; g < gbase + nt; g += G) cvt_tile(src, K, N, dst, g - gbase, smem);
  return gbase + nt;
}

__device__ __forceinline__ void hyena_h2_phase(const Params& P, char* smem) {
  float* zs = (float*)smem;
  float* h1s = zs + 8 * 64;
  float* w1s = h1s + 8 * 64;
  float* w2s = w1s + 33 * 64;
  const int tid = tid_(), wave = tid >> 6, lane = tid & 63;
  __syncthreads();
  for (int i = tid; i < 33 * 64; i += NT) w1s[i] = P.hy_f_w1[i];
  for (int i = tid; i < 64 * 64; i += NT) w2s[i] = P.hy_f_w2[i];
  const float fq0 = P.hy_freq[lane], fq1 = P.hy_freq[64 + lane], b1 = P.hy_f_b1[lane], b2 = P.hy_f_b2[lane];
  __syncthreads();
  for (int base = blockIdx.x * 8; base < 16640; base += gridDim.x * 8) {
    const int idx = base + wave;
    const int L = idx < LSEQ ? LSEQ : 256, n = idx < LSEQ ? idx : idx - LSEQ;
    float zv = 0.f;
    if (lane == 0) zv = (float)n / (float)(L - 1);
    else if (lane < 33) {
      int i = (lane - 1) & 15;
      float fr = 1e-4f + (float)i * ((15.f - 1e-4f) / 15.f);
      float w = (6.283185307179586f * (float)n) / (float)L;
      float a = fr * w;
      zv = lane < 17 ? cosf(a) : -sinf(a);
    }
    zs[wave * 64 + lane] = zv;
    __syncthreads();
    float acc = b1;
#pragma unroll 11
    for (int i = 0; i < 33; ++i) acc += zs[wave * 64 + i] * w1s[i * 64 + lane];
    h1s[wave * 64 + lane] = sinf(fq0 * acc);
    __syncthreads();
    float acc2 = b2;
#pragma unroll 16
    for (int i = 0; i < 64; ++i) acc2 += h1s[wave * 64 + i] * w2s[i * 64 + lane];
    float h2 = sinf(fq1 * acc2);
    if (idx < LSEQ) P.h2b[(size_t)n * 64 + lane] = f2bf(h2); else P.h2cb[(size_t)n * 64 + lane] = f2bf(h2);
    __syncthreads();
  }
}

__device__ __forceinline__ void norm_phase(const float* xlat, const float* xctx, const float* nw, const float* modl, int chunk_shift, bf16_t* H, int nrows, int perm,
                                           const float* part = nullptr, const float* gate_ctx = nullptr, float* xc_out = nullptr) {
  const int tid = tid_(), wave = tid >> 6, lane = tid & 63;
  for (int row = blockIdx.x * 8 + wave; row < nrows; row += gridDim.x * 8) {
    const float* src = row < MLAT ? xlat + (size_t)row * 2048 : xctx + (size_t)(row - MLAT) * 2048;
    const int which = row < MLAT ? (row >> 14) : 2;
    float4 v[8]; float ss = 0.f;
#pragma unroll
    for (int i = 0; i < 8; ++i) v[i] = *(const float4*)(src + (i * 64 + lane) * 4);
    if (part != nullptr && row >= MLAT) {
#pragma unroll
      for (int i = 0; i < 8; ++i) {
        const int col = (i * 64 + lane) * 4;
        float4 a = make_float4(0.f, 0.f, 0.f, 0.f);
#pragma unroll
        for (int ks = 0; ks < 8; ++ks) { const float4 pq = *(const float4*)(part + ((size_t)ks * 512 + (row - MLAT)) * 2048 + col); a.x += pq.x; a.y += pq.y; a.z += pq.z; a.w += pq.w; }
        const float4 g = *(const float4*)(gate_ctx + col);
        v[i].x += g.x * a.x; v[i].y += g.y * a.y; v[i].z += g.z * a.z; v[i].w += g.w * a.w;
        *(float4*)(xc_out + (size_t)(row - MLAT) * 2048 + col) = v[i];
      }
    }
#pragma unroll
    for (int i = 0; i < 8; ++i) ss += v[i].x * v[i].x + v[i].y * v[i].y + v[i].z * v[i].z + v[i].w * v[i].w;
    ss = wave_sum(ss);
    const float rs = rsqrtf(ss * (1.f / 2048.f) + 1e-6f);
    int drow = row;
    if (perm && row < MLAT) { int t = row & (LSEQ - 1); drow = (row & ~(LSEQ - 1)) + (t & 63) * 256 + (t >> 6); }
    const float* sh = modl + which * 12288 + chunk_shift * 2048;
    const float* sc = sh + 2048;
#pragma unroll
    for (int i = 0; i < 8; ++i) {
      int col = (i * 64 + lane) * 4;
      float4 w = *(const float4*)(nw + col), s1 = *(const float4*)(sc + col), s0 = *(const float4*)(sh + col);
      float o0 = v[i].x * rs * w.x * (1.f + s1.x) + s0.x, o1 = v[i].y * rs * w.y * (1.f + s1.y) + s0.y;
      float o2 = v[i].z * rs * w.z * (1.f + s1.z) + s0.z, o3 = v[i].w * rs * w.w * (1.f + s1.w) + s0.w;
      uint2 u; u.x = pack2(o0, o1); u.y = pack2(o2, o3);
      *(uint2*)(H + (size_t)drow * 2048 + col) = u;
    }
  }
}

__device__ __forceinline__ void final_norm_phase(float* xl, const float* w) {
  const int tid = tid_(), wave = tid >> 6, lane = tid & 63;
  for (int row = blockIdx.x * 8 + wave; row < MLAT; row += gridDim.x * 8) {
    float* src = xl + (size_t)row * 2048;
    float4 v[8]; float ss = 0.f;
#pragma unroll
    for (int i = 0; i < 8; ++i) {
      v[i] = *(const float4*)(src + (i * 64 + lane) * 4);
      ss += v[i].x * v[i].x + v[i].y * v[i].y + v[i].z * v[i].z + v[i].w * v[i].w;
    }
    ss = wave_sum(ss);
    const float rs = rsqrtf(ss * (1.f / 2048.f) + 1e-6f);
#pragma unroll
    for (int i = 0; i < 8; ++i) {
      int col = (i * 64 + lane) * 4;
      float4 ww = *(const float4*)(w + col);
      float4 o = make_float4(v[i].x * rs * ww.x, v[i].y * rs * ww.y, v[i].z * rs * ww.z, v[i].w * rs * ww.w);
      *(float4*)(src + col) = o;
    }
  }
}

__device__ __forceinline__ int swz(int i) { return i ^ (((i >> 5) & 1) * 5) ^ (((i >> 6) & 1) * 26); }
__device__ __forceinline__ void fft_twid(const float2* TW, int kt, float2& w1, float2& w2, float2& w3) {
  w1 = cmul(TW[kt >> 7], TW[128 + (kt & 127)]); w2 = cmul(w1, w1); w3 = cmul(w2, w1);
}
__device__ __forceinline__ void fft_fwd(float2* X, const float2* TW) {
  const int tid = tid_();
#pragma unroll 1
  for (int lq = 12; lq >= 0; lq -= 2) {
    const int q = 1 << lq, tws = 4096 >> lq;
    const bool big = lq >= 10;
    float2 w1, w2, w3;
    if (!big) fft_twid(TW, (tid & (q - 1)) * tws, w1, w2, w3);
#pragma unroll 4
    for (int i = 0; i < 8; ++i) {
      const int bidx = tid + NT * i, j = bidx & (q - 1), base = ((bidx >> lq) << (lq + 2)) + j;
      int i0, i1, i2, i3;
      if (big) { i0 = swz(base); i1 = i0 + q; i2 = i1 + q; i3 = i2 + q; fft_twid(TW, j * tws, w1, w2, w3); }
      else { i0 = swz(base); i1 = swz(base + q); i2 = swz(base + 2 * q); i3 = swz(base + 3 * q); }
      float2 a0 = X[i0], a1 = X[i1], a2 = X[i2], a3 = X[i3];
      float2 t0 = make_float2(a0.x + a2.x, a0.y + a2.y), t1 = make_float2(a0.x - a2.x, a0.y - a2.y);
      float2 t2 = make_float2(a1.x + a3.x, a1.y + a3.y), d = make_float2(a1.x - a3.x, a1.y - a3.y);
      float2 t3 = make_float2(d.y, -d.x);
      float2 y0 = make_float2(t0.x + t2.x, t0.y + t2.y), y1 = make_float2(t1.x + t3.x, t1.y + t3.y);
      float2 y2 = make_float2(t0.x - t2.x, t0.y - t2.y), y3 = make_float2(t1.x - t3.x, t1.y - t3.y);
      X[i0] = y0; X[i1] = cmul(y1, w1); X[i2] = cmul(y2, w2); X[i3] = cmul(y3, w3);
    }
    __syncthreads();
  }
}
__device__ __forceinline__ void fft_inv(float2* X, const float2* TW) {
  const int tid = tid_();
#pragma unroll 1
  for (int lq = 0; lq <= 12; lq += 2) {
    const int q = 1 << lq, tws = 4096 >> lq;
    const bool big = lq >= 10;
    float2 w1, w2, w3;
    if (!big) fft_twid(TW, (tid & (q - 1)) * tws, w1, w2, w3);
#pragma unroll 4
    for (int i = 0; i < 8; ++i) {
      const int bidx = tid + NT * i, j = bidx & (q - 1), base = ((bidx >> lq) << (lq + 2)) + j;
      int i0, i1, i2, i3;
      if (big) { i0 = swz(base); i1 = i0 + q; i2 = i1 + q; i3 = i2 + q; fft_twid(TW, j * tws, w1, w2, w3); }
      else { i0 = swz(base); i1 = swz(base + q); i2 = swz(base + 2 * q); i3 = swz(base + 3 * q); }
      float2 b0 = X[i0], b1 = cmulc(X[i1], w1), b2 = cmulc(X[i2], w2), b3 = cmulc(X[i3], w3);
      float2 t0 = make_float2(b0.x + b2.x, b0.y + b2.y), t1 = make_float2(b0.x - b2.x, b0.y - b2.y);
      float2 t2 = make_float2(b1.x + b3.x, b1.y + b3.y), d = make_float2(b1.x - b3.x, b1.y - b3.y);
      float2 t3 = make_float2(-d.y, d.x);
      X[i0] = make_float2(t0.x + t2.x, t0.y + t2.y); X[i1] = make_float2(t1.x + t3.x, t1.y + t3.y);
      X[i2] = make_float2(t0.x - t2.x, t0.y - t2.y); X[i3] = make_float2(t1.x - t3.x, t1.y - t3.y);
    }
    __syncthreads();
  }
}

__device__ __forceinline__ float conv3_at(const bf16_t* __restrict__ col, int n, int len, float w0, float w1, float w2, float bb) {
  float c = bf2f(col[n]);
  float p = n > 0 ? bf2f(col[n - 1]) : 0.f;
  float x = n < len - 1 ? bf2f(col[n + 1]) : 0.f;
  return bb + w0 * p + w1 * c + w2 * x;
}

__device__ __forceinline__ void hyena_channel(const Params& P, int c, char* smem) {
  float2* X = (float2*)smem;
  float* red = (float*)(smem + 131072);
  const int tid = tid_();
  const float2* TW = (const float2*)(smem + 131072 + 1024);
  const float2* __restrict__ HF = P.half;
  const bf16_t* pv = P.RP + (size_t)c * MALL;
  const bf16_t* px1 = P.RP + (size_t)(1024 + c) * MALL;
  const bf16_t* px2 = P.RP + (size_t)(2048 + c) * MALL;
  const float* cw = P.hy_conv_w; const float* cb = P.hy_conv_b;
  const float vw0 = cw[c], vw1 = cw[3072 + c], vw2 = cw[6144 + c], vb = cb[c];
  const float aw0 = cw[1024 + c], aw1 = cw[3072 + 1024 + c], aw2 = cw[6144 + 1024 + c], ab = cb[1024 + c];
  const float bw0 = cw[2048 + c], bw1 = cw[3072 + 2048 + c], bw2 = cw[6144 + 2048 + c], bb = cb[2048 + c];
  const float dlo = -3.0701134573253944f, dhi = -15.350567286626972f;
  const float delta = fabsf(dlo + (dhi - dlo) * ((float)c / 1023.f));
  const float* taps = P.out;
  float2 K[32];
  float2* __restrict__ Rg = (float2*)(P.RA + (size_t)3 * MALL * 1024) + (size_t)blockIdx.x * (2 * LSEQ);
  float2* __restrict__ Zg = Rg + LSEQ;
#pragma unroll 8
  for (int i = 0; i < 32; ++i) {
    const int n = tid + NT * i;
    Zg[n] = make_float2(conv3_at(pv, n, LSEQ, vw0, vw1, vw2, vb), conv3_at(pv + LSEQ, n, LSEQ, vw0, vw1, vw2, vb));
  }
#pragma unroll 1
  for (int o = 0; o < 2; ++o) {
    const float* tl = taps + (size_t)(o * 2048 + c) * LSEQ;
    const float* th = taps + (size_t)(o * 2048 + 1024 + c) * LSEQ;
    const float bias = P.hy_bias[o * 1024 + c];
    float nrm = 0.f;
    __syncthreads();
#pragma unroll 8
    for (int i = 0; i < 32; ++i) {
      const int n = tid + NT * i;
      float lo = tl[n] * expf(-((float)n / 16383.f) * delta);
      float hi = n > 0 ? th[LSEQ - n] * expf(-((float)(LSEQ - n) / 16383.f) * delta) : 0.f;
      X[swz(n)] = make_float2(lo + hi, 0.f);
      nrm += fabsf(lo) + fabsf(hi);
    }
    const float norm = block_sum(nrm, red);
    fft_fwd(X, TW);
#pragma unroll
    for (int i = 0; i < 32; ++i) K[i] = X[swz(tid + NT * i)];
    __syncthreads();
#pragma unroll 8
    for (int i = 0; i < 32; ++i) X[swz(tid + NT * i)] = Zg[tid + NT * i];
    __syncthreads();
    fft_fwd(X, TW);
#pragma unroll
    for (int i = 0; i < 32; ++i) { const int n = tid + NT * i; X[swz(n)] = cmul(X[swz(n)], K[i]); }
    __syncthreads();
    fft_inv(X, TW);
#pragma unroll 8
    for (int i = 0; i < 32; ++i) Rg[tid + NT * i] = X[swz(tid + NT * i)];
    __syncthreads();
#pragma unroll 8
    for (int i = 0; i < 32; ++i) {
      const int n = tid + NT * i;
      float lo = tl[n] * expf(-((float)n / 16383.f) * delta);
      float hi = n > 0 ? th[LSEQ - n] * expf(-((float)(LSEQ - n) / 16383.f) * delta) : 0.f;
      float2 h = HF[n];
      float dd = lo - hi;
      X[swz(n)] = make_float2(dd * h.x, dd * h.y);
    }
    __syncthreads();
    fft_fwd(X, TW);
#pragma unroll
    for (int i = 0; i < 32; ++i) K[i] = X[swz(tid + NT * i)];
    __syncthreads();
#pragma unroll 8
    for (int i = 0; i < 32; ++i) { const int n = tid + NT * i; X[swz(n)] = cmul(Zg[n], HF[n]); }
    __syncthreads();
    fft_fwd(X, TW);
#pragma unroll
    for (int i = 0; i < 32; ++i) { const int n = tid + NT * i; X[swz(n)] = cmul(X[swz(n)], K[i]); }
    __syncthreads();
    fft_inv(X, TW);
    const float sc = 0.5f / (16384.f * norm);
#pragma unroll 8
    for (int i = 0; i < 32; ++i) {
      const int n = tid + NT * i;
      float2 t = cmulc(X[swz(n)], HF[n]);
      float2 rr = Rg[n], zz = Zg[n];
      float y0 = (rr.x + t.x) * sc + zz.x * bias;
      float y1 = (rr.y + t.y) * sc + zz.y * bias;
      if (o == 0) {
        Zg[n] = make_float2(conv3_at(px1, n, LSEQ, aw0, aw1, aw2, ab) * y0, conv3_at(px1 + LSEQ, n, LSEQ, aw0, aw1, aw2, ab) * y1);
      } else {
        float o0 = conv3_at(px2, n, LSEQ, bw0, bw1, bw2, bb) * y0;
        float o1 = conv3_at(px2 + LSEQ, n, LSEQ, bw0, bw1, bw2, bb) * y1;
        P.RP[(size_t)c * MALL + n] = f2bf(o0);
        P.RP[(size_t)c * MALL + LSEQ + n] = f2bf(o1);
      }
    }
    __syncthreads();
  }
}

__device__ __forceinline__ void hyena_ctx_channel(const Params& P, int c, char* smem) {
  float* Kf = (float*)smem;
  float* u = Kf + 1024;
  float* z = u + 512;
  float* red = z + 512;
  const int tid = tid_(), b = tid >> 8, t = tid & 255;
  const float dlo = -3.0701134573253944f, dhi = -15.350567286626972f;
  const float delta = fabsf(dlo + (dhi - dlo) * ((float)c / 1023.f));
  const float* cw = P.hy_conv_w; const float* cb = P.hy_conv_b;
  float nrm[2];
  __syncthreads();
  {
    const int o = b, n = t;
    float dec = expf(-((float)n / 255.f) * delta);
    float lo = P.tapsc[(size_t)(o * 2048 + c) * 256 + n] * dec;
    float hi = n > 0 ? P.tapsc[(size_t)(o * 2048 + 1024 + c) * 256 + n] * dec : 0.f;
    Kf[o * 512 + 256 + n] = lo;
    if (n > 0) Kf[o * 512 + 256 - n] = hi;
    float v = fabsf(lo) + fabsf(hi);
    v = wave_sum(v);
    if ((tid & 63) == 0) red[tid >> 6] = v;
  }
  const bf16_t* pv = P.RP + (size_t)c * MALL + MLAT + b * 256;
  const bf16_t* px1 = P.RP + (size_t)(1024 + c) * MALL + MLAT + b * 256;
  const bf16_t* px2 = P.RP + (size_t)(2048 + c) * MALL + MLAT + b * 256;
  u[b * 256 + t] = conv3_at(pv, t, 256, cw[c], cw[3072 + c], cw[6144 + c], cb[c]);
  __syncthreads();
  nrm[0] = red[0] + red[1] + red[2] + red[3];
  nrm[1] = red[4] + red[5] + red[6] + red[7];
  float acc = 0.f;
  for (int s = 0; s < 256; ++s) acc += Kf[256 + t - s] * u[b * 256 + s];
  float y1 = acc / nrm[0] + u[b * 256 + t] * P.hy_bias[c];
  float zz = conv3_at(px1, t, 256, cw[1024 + c], cw[3072 + 1024 + c], cw[6144 + 1024 + c], cb[1024 + c]) * y1;
  z[b * 256 + t] = zz;
  __syncthreads();
  acc = 0.f;
  for (int s = 0; s < 256; ++s) acc += Kf[512 + 256 + t - s] * z[b * 256 + s];
  float y2 = acc / nrm[1] + zz * P.hy_bias[1024 + c];
  float o2 = conv3_at(px2, t, 256, cw[2048 + c], cw[3072 + 2048 + c], cw[6144 + 2048 + c], cb[2048 + c]) * y2;
  P.RP[(size_t)c * MALL + MLAT + b * 256 + t] = f2bf(o2);
  __syncthreads();
}

__device__ __forceinline__ void hyena_transpose_phase(const Params& P, char* smem) {
  bf16_t* t = (bf16_t*)smem;
  const int tid = tid_();
  for (int tile = blockIdx.x; tile < 520 * 16; tile += gridDim.x) {
    const int r0 = (tile >> 4) * 64, c0 = (tile & 15) * 64;
    __syncthreads();
    {
      const int ch = tid >> 3, r8 = (tid & 7) * 8;
      bf16x8 v = *(const bf16x8*)(P.RP + (size_t)(c0 + ch) * MALL + r0 + r8);
#pragma unroll
      for (int j = 0; j < 8; ++j) t[(r8 + j) * 66 + ch] = (bf16_t)v[j];
    }
    __syncthreads();
    {
      const int r = tid >> 3, c8 = (tid & 7) * 8;
      bf16x8 o;
#pragma unroll
      for (int j = 0; j < 8; ++j) o[j] = (short)t[r * 66 + c8 + j];
      *(bf16x8*)(P.H + (size_t)(r0 + r) * 2048 + c0 + c8) = o;
    }
  }
  __syncthreads();
}

typedef float f32x2 __attribute__((ext_vector_type(2)));
__device__ __forceinline__ float dpp_add(float v, float src_unused) { return v; }
__device__ __forceinline__ float oct_sum(float v) {
  v += __int_as_float(__builtin_amdgcn_mov_dpp(__float_as_int(v), 0xB1, 0xf, 0xf, true));
  v += __int_as_float(__builtin_amdgcn_mov_dpp(__float_as_int(v), 0x4E, 0xf, 0xf, true));
  v += __int_as_float(__builtin_amdgcn_mov_dpp(__float_as_int(v), 0x141, 0xf, 0xf, true));
  return v;
}
__device__ __forceinline__ void rwkv_scan_task(const Params& P, int task, char* smem) {
  const int tid = tid_(), wave = __builtin_amdgcn_readfirstlane(tid >> 6), lane = tid & 63;
  const int hf = task & 1, dir = (task >> 1) & 1, h = (task >> 2) & 15, b = task >> 6;
  const bf16_t* prw = P.RP + (size_t)3072 * MALL;
  bf16_t* W2t = (bf16_t*)smem;
  bf16_t* A2t = W2t + 64 * 104;
  bf16_t* Aw = A2t + 64 * 104;
  bf16_t* Aa = Aw + 32 * 104;
  float* cst = (float*)(Aa + 32 * 104);
  float* fb = cst + 320;
  float* ybufs = fb + 2 * 11264;
  bf16_t* yout = P.RA + (size_t)dir * MALL * 1024;
  __syncthreads();
  for (int i = tid; i < 96 * 64; i += NT) {
    int r = i >> 6, d = i & 63;
    W2t[d * 104 + r] = f2bf(P.rw_w2[(size_t)(dir * 96 + r) * 1024 + h * 64 + d]);
    A2t[d * 104 + r] = f2bf(P.rw_a2[(size_t)(dir * 96 + r) * 1024 + h * 64 + d]);
  }
  if (tid < 64) {
    cst[tid] = P.rw_w0[dir * 1024 + h * 64 + tid];
    cst[64 + tid] = P.rw_a0[dir * 1024 + h * 64 + tid];
    cst[128 + tid] = P.rw_k_k[h * 64 + tid];
    cst[192 + tid] = P.rw_k_a[h * 64 + tid];
    cst[256 + tid] = P.rw_r_k[h * 64 + tid];
  }
  __syncthreads();
#define RW_BAR() do { asm volatile("s_waitcnt lgkmcnt(0)" ::: "memory"); __builtin_amdgcn_s_barrier(); asm volatile("" ::: "memory"); } while (0)
  if (wave >= 4) {
    __builtin_amdgcn_s_setprio(3);
    const int rw = (wave - 4) * 8 + (lane >> 3), q = lane & 7;
    f32x2 S[4];
#pragma unroll
    for (int i = 0; i < 4; ++i) S[i] = (f32x2){0.f, 0.f};
    RW_BAR(); RW_BAR(); RW_BAR();
#define RWC_LOAD(J, K4, D4, A4, E4, R4, VV) do { const float* fj = F + (J) * 64 + 8 * q; \
      _Pragma("unroll") for (int i = 0; i < 2; ++i) { K4[i] = ((const float4*)(fj + 6144))[i]; D4[i] = ((const float4*)fj)[i]; A4[i] = ((const float4*)(fj + 4096))[i]; \
        E4[i] = ((const float4*)(fj + 2048))[i]; R4[i] = ((const float4*)(fj + 8192))[i]; } VV = F[10240 + (J) * 32 + rw]; } while (0)
#define LO2(X) ((f32x2){(X).x, (X).y})
#define HI2(X) ((f32x2){(X).z, (X).w})
#define RWC_STEP(J, K4, D4, A4, E4, R4, VV) do { \
      f32x2 sp = S[0] * LO2(K4[0]); sp = S[1] * HI2(K4[0]) + sp; sp = S[2] * LO2(K4[1]) + sp; sp = S[3] * HI2(K4[1]) + sp; \
      const float sa = -oct_sum(sp.x + sp.y); \
      const f32x2 sa2 = (f32x2){sa, sa}, vv2 = (f32x2){VV, VV}; \
      f32x2 t0 = vv2 * LO2(E4[0]), t1 = vv2 * HI2(E4[0]), t2 = vv2 * LO2(E4[1]), t3 = vv2 * HI2(E4[1]); \
      t0 = sa2 * LO2(A4[0]) + t0; t1 = sa2 * HI2(A4[0]) + t1; t2 = sa2 * LO2(A4[1]) + t2; t3 = sa2 * HI2(A4[1]) + t3; \
      S[0] = S[0] * LO2(D4[0]) + t0; S[1] = S[1] * HI2(D4[0]) + t1; S[2] = S[2] * LO2(D4[1]) + t2; S[3] = S[3] * HI2(D4[1]) + t3; \
      f32x2 yp = S[0] * LO2(R4[0]); yp = S[1] * HI2(R4[0]) + yp; yp = S[2] * LO2(R4[1]) + yp; yp = S[3] * HI2(R4[1]) + yp; \
      const float y = oct_sum(yp.x + yp.y); \
      if (q == 0) yb[(J) * 32 + rw] = y; } while (0)
#pragma unroll 1
    for (int ci = 0; ci < 520; ++ci) {
      const float* F = fb + (ci & 1) * 11264;
      float* yb = ybufs + (ci & 1) * 1024;
      float4 kA[2], dA[2], aA[2], eA[2], rA[2], kB[2], dB[2], aB[2], eB[2], rB[2];
      float vA, vB;
      RWC_LOAD(0, kA, dA, aA, eA, rA, vA);
#pragma unroll 1
      for (int j = 0; j < 32; j += 2) {
        RWC_LOAD(j + 1, kB, dB, aB, eB, rB, vB);
        RWC_STEP(j, kA, dA, aA, eA, rA, vA);
        if (j + 2 < 32) RWC_LOAD(j + 2, kA, dA, aA, eA, rA, vA);
        RWC_STEP(j + 1, kB, dB, aB, eB, rB, vB);
        if (j == 14 || j == 22 || j == 30) RW_BAR();
      }
    }
#undef RWC_LOAD
#undef RWC_STEP
#undef LO2
#undef HI2
    __builtin_amdgcn_s_setprio(0);
  } else {
    int itok[6], icol[6], ikind[6];
#pragma unroll
    for (int i = 0; i < 6; ++i) {
      const int id = tid + 256 * i;
      int kind = -1, tok = 0, col = 0;
      if (id < 640) {
        tok = id / 20; const int rem = id % 20;
        if (rem < 8) { kind = 0; col = h * 64 + rem * 8; }
        else if (rem < 16) { kind = 1; col = 1024 + h * 64 + (rem - 8) * 8; }
        else { kind = 2; col = 2048 + h * 64 + hf * 32 + (rem - 16) * 8; }
      } else if (id < 1408) {
        const int id2 = id - 640; tok = id2 / 24; const int rem = id2 % 24, which = rem / 12, k8 = (rem % 12) * 8;
        col = (which ? 3264 : 3072) + dir * 96 + k8; kind = 3 + which;
      }
      itok[i] = tok; icol[i] = col; ikind[i] = kind;
    }
    bf16x8 lc[6], lp[6], ln[6];
    const bf16x8 z8 = {0, 0, 0, 0, 0, 0, 0, 0};
#define RW_ISSUE(CI) do { _Pragma("unroll") for (int i = 0; i < 6; ++i) { lc[i] = z8; lp[i] = z8; ln[i] = z8; \
      if (ikind[i] >= 0 && (CI) < 520) { int pos, len; const int row = step_row((CI) * 32 + itok[i], b, dir, pos, len); \
        const bf16_t* p = prw + (size_t)row * 3712 + icol[i]; lc[i] = *(const bf16x8*)p; \
        if (pos > 0) lp[i] = *(const bf16x8*)(p - 3712); if (pos < len - 1) ln[i] = *(const bf16x8*)(p + 3712); } } } while (0)
    RW_ISSUE(0);
#pragma unroll 1
    for (int ci = -1; ci < 520; ++ci) {
      const int cn = ci + 1;
      float* F = fb + (cn & 1) * 11264;
      if (cn < 520) {
#pragma unroll
        for (int i = 0; i < 6; ++i) {
          if (ikind[i] >= 0) {
            const float4 m0 = *(const float4*)(P.rw_mu + icol[i]), m1 = *(const float4*)(P.rw_mu + icol[i] + 4);
            const float mu[8] = {m0.x, m0.y, m0.z, m0.w, m1.x, m1.y, m1.z, m1.w};
            float vv[8];
#pragma unroll
            for (int j = 0; j < 8; ++j) {
              float cc = bf2f((bf16_t)lc[i][j]), pp = bf2f((bf16_t)lp[i][j]), nn = bf2f((bf16_t)ln[i][j]);
              vv[j] = cc + (0.5f * (pp + nn) - cc) * mu[j];
            }
            const int tok = itok[i], c8 = icol[i] & 63;
            if (ikind[i] == 0) {
              *(float4*)(F + 8192 + tok * 64 + c8) = make_float4(vv[0], vv[1], vv[2], vv[3]);
              *(float4*)(F + 8192 + tok * 64 + c8 + 4) = make_float4(vv[4], vv[5], vv[6], vv[7]);
            } else if (ikind[i] == 1) {
              *(float4*)(F + 2048 + tok * 64 + c8) = make_float4(vv[0], vv[1], vv[2], vv[3]);
              *(float4*)(F + 2048 + tok * 64 + c8 + 4) = make_float4(vv[4], vv[5], vv[6], vv[7]);
            } else if (ikind[i] == 2) {
              *(float4*)(F + 10240 + tok * 32 + (c8 & 31)) = make_float4(vv[0], vv[1], vv[2], vv[3]);
              *(float4*)(F + 10240 + tok * 32 + (c8 & 31) + 4) = make_float4(vv[4], vv[5], vv[6], vv[7]);
            } else {
              const int k8 = (icol[i] - (ikind[i] == 3 ? 3072 : 3264) - dir * 96);
              bf16x8 o;
              if (ikind[i] == 3) {
#pragma unroll
                for (int j = 0; j < 8; ++j) o[j] = (short)f2bf(2.f * fsig(2.f * vv[j]) - 1.f);
                *(bf16x8*)(Aw + tok * 104 + k8) = o;
              } else {
#pragma unroll
                for (int j = 0; j < 8; ++j) o[j] = (short)f2bf(vv[j]);
                *(bf16x8*)(Aa + tok * 104 + k8) = o;
              }
            }
          }
        }
      }
      RW_ISSUE(cn + 1);
      RW_BAR();
      if (cn < 520) {
        const int fr = lane & 15, fq = lane >> 4;
#pragma unroll 1
        for (int tt = wave; tt < 16; tt += 4) {
          const int mat = tt >> 3, mt = (tt >> 2) & 1, nt = tt & 3;
          const bf16_t* As = mat ? Aa : Aw;
          const bf16_t* Bs = mat ? A2t : W2t;
          f32x4 acc = {0.f, 0.f, 0.f, 0.f};
#pragma unroll
          for (int ks = 0; ks < 3; ++ks) {
            bf16x8 a = *(const bf16x8*)(As + (mt * 16 + fr) * 104 + ks * 32 + fq * 8);
            bf16x8 bb = *(const bf16x8*)(Bs + (nt * 16 + fr) * 104 + ks * 32 + fq * 8);
            acc = __builtin_amdgcn_mfma_f32_16x16x32_bf16(bb, a, acc, 0, 0, 0);
          }
          const int tok = mt * 16 + fr, d0 = nt * 16 + fq * 4;
          float4 c4 = *(const float4*)(cst + mat * 64 + d0), o4;
          if (mat == 0) {
            o4.x = __expf(-0.6065306597126334f * fsig(c4.x + acc[0])); o4.y = __expf(-0.6065306597126334f * fsig(c4.y + acc[1]));
            o4.z = __expf(-0.6065306597126334f * fsig(c4.z + acc[2])); o4.w = __expf(-0.6065306597126334f * fsig(c4.w + acc[3]));
            *(float4*)(F + tok * 64 + d0) = o4;
          } else {
            o4.x = fsig(c4.x + acc[0]); o4.y = fsig(c4.y + acc[1]); o4.z = fsig(c4.z + acc[2]); o4.w = fsig(c4.w + acc[3]);
            *(float4*)(F + 4096 + tok * 64 + d0) = o4;
          }
        }
      }
      RW_BAR();
      if (ci >= 1) {
        const float* yb = ybufs + ((ci - 1) & 1) * 1024;
#pragma unroll
        for (int r = 0; r < 4; ++r) {
          const int id = tid + 256 * r, tok = id >> 5, vx = id & 31;
          int pos, len; const int row = step_row((ci - 1) * 32 + tok, b, dir, pos, len);
          yout[(size_t)row * 1024 + h * 64 + hf * 32 + vx] = f2bf(yb[id]);
        }
      }
      if (cn < 520) {
#pragma unroll 1
        for (int it = tid; it < 512; it += 256) {
          const int tok = it >> 4, d4 = (it & 15) * 4;
          const float4 k4 = *(const float4*)(F + 2048 + tok * 64 + d4), a4 = *(const float4*)(F + 4096 + tok * 64 + d4), r4 = *(const float4*)(F + 8192 + tok * 64 + d4);
          const float4 ck = *(const float4*)(cst + 128 + d4), ca = *(const float4*)(cst + 192 + d4), cr = *(const float4*)(cst + 256 + d4);
          const float kv[4] = {k4.x, k4.y, k4.z, k4.w}, av[4] = {a4.x, a4.y, a4.z, a4.w}, rv[4] = {r4.x, r4.y, r4.z, r4.w};
          const float ckv[4] = {ck.x, ck.y, ck.z, ck.w}, cav[4] = {ca.x, ca.y, ca.z, ca.w}, crv[4] = {cr.x, cr.y, cr.z, cr.w};
          float kkv[4], kd[4], ss = 0.f, bn = 0.f;
#pragma unroll
          for (int j = 0; j < 4; ++j) {
            kkv[j] = kv[j] * ckv[j];
            ss += kkv[j] * kkv[j];
            kd[j] = kv[j] * (1.f + (av[j] - 1.f) * cav[j]);
            bn += rv[j] * kd[j] * crv[j];
          }
#pragma unroll
          for (int m = 8; m >= 1; m >>= 1) { ss += __shfl_xor(ss, m); bn += __shfl_xor(bn, m); }
          const float inv = rsqrtf(fmaxf(ss, 1e-24f));
          *(float4*)(F + 6144 + tok * 64 + d4) = make_float4(kkv[0] * inv, kkv[1] * inv, kkv[2] * inv, kkv[3] * inv);
          *(float4*)(F + 2048 + tok * 64 + d4) = make_float4(kd[0], kd[1], kd[2], kd[3]);
          *(float4*)(F + 4096 + tok * 64 + d4) = make_float4(kkv[0] * inv * av[0], kkv[1] * inv * av[1], kkv[2] * inv * av[2], kkv[3] * inv * av[3]);
          if (hf == 0 && (it & 15) == 0) {
            int pos, len; const int row = step_row(cn * 32 + tok, b, dir, pos, len);
            P.bonus[((size_t)dir * MALL + row) * 16 + h] = bn;
          }
        }
      }
      RW_BAR();
    }
#undef RW_ISSUE
#undef RW_BAR
  }
  __syncthreads();
  {
    const float* yb = ybufs + (519 & 1) * 1024;
#pragma unroll
    for (int r = 0; r < 2; ++r) {
      const int id = tid + NT * r, tok = id >> 5, vx = id & 31;
      int pos, len; const int row = step_row(519 * 32 + tok, b, dir, pos, len);
      yout[(size_t)row * 1024 + h * 64 + hf * 32 + vx] = f2bf(yb[id]);
    }
  }
  __syncthreads();
}

__device__ __forceinline__ void rwkv_readout_phase(const Params& P) {
  const int tid = tid_(), wave = tid >> 6, lane = tid & 63;
  const bf16_t* __restrict__ prw = P.RP + (size_t)3072 * MALL;
  const bf16_t* __restrict__ yf = P.RA; const bf16_t* __restrict__ yb = P.RA + (size_t)MALL * 1024; const bf16_t* __restrict__ g = P.RA + (size_t)2 * MALL * 1024;
  bf16_t* __restrict__ Hout = P.H;
  for (int row = blockIdx.x * 8 + wave; row < MALL; row += gridDim.x * 8)
#pragma unroll
  for (int hq = 0; hq < 4; ++hq) {
    const int h = hq * 4 + (lane >> 4), d4 = (lane & 15) * 4, col = h * 64 + d4;
    int pos, len; row_info(row, pos, len);
    uint2 uf = *(const uint2*)(yf + (size_t)row * 1024 + col), ub = *(const uint2*)(yb + (size_t)row * 1024 + col);
    float y[4];
    y[0] = bf2f(uf.x & 0xffff) + bf2f(ub.x & 0xffff); y[1] = bf2f(uf.x >> 16) + bf2f(ub.x >> 16);
    y[2] = bf2f(uf.y & 0xffff) + bf2f(ub.y & 0xffff); y[3] = bf2f(uf.y >> 16) + bf2f(ub.y >> 16);
    float s = y[0] + y[1] + y[2] + y[3];
#pragma unroll
    for (int m = 8; m >= 1; m >>= 1) s += __shfl_xor(s, m);
    const float mean = s * (1.f / 64.f);
    float vs = 0.f;
#pragma unroll
    for (int j = 0; j < 4; ++j) { float dd = y[j] - mean; vs += dd * dd; }
#pragma unroll
    for (int m = 8; m >= 1; m >>= 1) vs += __shfl_xor(vs, m);
    const float rs = rsqrtf(vs * (1.f / 64.f) + 64e-5f);
    const float bn = P.bonus[(size_t)row * 16 + h] + P.bonus[((size_t)MALL + row) * 16 + h];
    const bf16_t* pp = prw + (size_t)row * 3712 + 2048 + col;
    uint2 cu = *(const uint2*)pp, z2 = make_uint2(0, 0);
    uint2 pu = pos > 0 ? *(const uint2*)(pp - 3712) : z2;
    uint2 nu = pos < len - 1 ? *(const uint2*)(pp + 3712) : z2;
    float cv[4] = {bf2f(cu.x & 0xffff), bf2f(cu.x >> 16), bf2f(cu.y & 0xffff), bf2f(cu.y >> 16)};
    float pv[4] = {bf2f(pu.x & 0xffff), bf2f(pu.x >> 16), bf2f(pu.y & 0xffff), bf2f(pu.y >> 16)};
    float nv[4] = {bf2f(nu.x & 0xffff), bf2f(nu.x >> 16), bf2f(nu.y & 0xffff), bf2f(nu.y >> 16)};
    uint2 gu = *(const uint2*)(g + (size_t)row * 1024 + col);
    float gv[4] = {bf2f(gu.x & 0xffff), bf2f(gu.x >> 16), bf2f(gu.y & 0xffff), bf2f(gu.y >> 16)};
    float o[4];
#pragma unroll
    for (int j = 0; j < 4; ++j) {
      float vsh = cv[j] + (0.5f * (pv[j] + nv[j]) - cv[j]) * P.rw_mu[2048 + col + j];
      float ln = (y[j] - mean) * rs * P.rw_ln_w[col + j] + P.rw_ln_b[col + j];
      o[j] = (ln + bn * vsh) * gv[j];
    }
    uint2 u; u.x = pack2(o[0], o[1]); u.y = pack2(o[2], o[3]);
    *(uint2*)(Hout + (size_t)row * 2048 + 1024 + col) = u;
  }
}

__device__ __forceinline__ float row16_sum(float v) {
  v += __int_as_float(__builtin_amdgcn_mov_dpp(__float_as_int(v), 0xB1, 0xf, 0xf, true));
  v += __int_as_float(__builtin_amdgcn_mov_dpp(__float_as_int(v), 0x4E, 0xf, 0xf, true));
  v += __int_as_float(__builtin_amdgcn_mov_dpp(__float_as_int(v), 0x141, 0xf, 0xf, true));
  v += __int_as_float(__builtin_amdgcn_mov_dpp(__float_as_int(v), 0x140, 0xf, 0xf, true));
  return v;
}
__device__ __forceinline__ void hgrn2_block_task(const Params& P, int t, char* smem) {
  const int tid = tid_(), wave = __builtin_amdgcn_readfirstlane(tid >> 6), lane = tid & 63;
  const int chain = t >> 3, vb = (t & 7) * 16, dir = chain & 1, h = (chain >> 1) & 7, b = chain >> 4;
  const bf16_t* p1 = P.RP;
  float* bufs = (float*)smem;
  __syncthreads();
  if (wave < 4) {
    __builtin_amdgcn_s_setprio(2);
    const int vi = lane >> 4, eg = lane & 15;
    bf16_t* oout = P.RA + (size_t)dir * MALL * 1024 + h * 128 + vb + wave * 4 + vi;
    const int rstep = dir ? -1 : 1;
    f32x2 S[4];
#pragma unroll
    for (int i = 0; i < 4; ++i) S[i] = (f32x2){0.f, 0.f};
    __syncthreads();
#pragma unroll 1
    for (int ci = 0; ci < 520; ++ci) {
      const float* B = bufs + (ci & 1) * 8704;
#pragma unroll 1
      for (int g = 0; g < 4; ++g) {
        int pos, len; const int r0 = step_row(ci * 32 + g * 8, b, dir, pos, len);
        float pov[8];
#pragma unroll
        for (int u = 0; u < 8; ++u) {
          const int s = g * 8 + u;
          const float4 qa = *(const float4*)(B + s * 128 + eg * 8), qb = *(const float4*)(B + s * 128 + eg * 8 + 4);
          const float4 ka = *(const float4*)(B + 4096 + s * 128 + eg * 8), kb = *(const float4*)(B + 4096 + s * 128 + eg * 8 + 4);
          const float vf = B[8192 + s * 16 + wave * 4 + vi];
          const f32x2 v2 = (f32x2){vf, vf};
          S[0] = (f32x2){ka.x, ka.y} * (v2 - S[0]) + S[0]; S[1] = (f32x2){ka.z, ka.w} * (v2 - S[1]) + S[1];
          S[2] = (f32x2){kb.x, kb.y} * (v2 - S[2]) + S[2]; S[3] = (f32x2){kb.z, kb.w} * (v2 - S[3]) + S[3];
          f32x2 po = (f32x2){qa.x, qa.y} * S[0];
          po = (f32x2){qa.z, qa.w} * S[1] + po; po = (f32x2){qb.x, qb.y} * S[2] + po; po = (f32x2){qb.z, qb.w} * S[3] + po;
          pov[u] = po.x + po.y;
        }
#pragma unroll
        for (int u = 0; u < 8; ++u) pov[u] += __int_as_float(__builtin_amdgcn_mov_dpp(__float_as_int(pov[u]), 0xB1, 0xf, 0xf, true));
#pragma unroll
        for (int u = 0; u < 8; ++u) pov[u] += __int_as_float(__builtin_amdgcn_mov_dpp(__float_as_int(pov[u]), 0x4E, 0xf, 0xf, true));
#pragma unroll
        for (int u = 0; u < 8; ++u) pov[u] += __int_as_float(__builtin_amdgcn_mov_dpp(__float_as_int(pov[u]), 0x141, 0xf, 0xf, true));
#pragma unroll
        for (int u = 0; u < 8; ++u) pov[u] += __int_as_float(__builtin_amdgcn_mov_dpp(__float_as_int(pov[u]), 0x140, 0xf, 0xf, true));
        if (eg == 0) {
#pragma unroll
          for (int u = 0; u < 8; ++u) oout[(size_t)(r0 + rstep * u) * 1024] = f2bf(pov[u]);
        }
      }
      __syncthreads();
    }
    __builtin_amdgcn_s_setprio(0);
  } else {
    const int pt = tid - 256;
    const int st0 = pt >> 4, c8 = (pt & 15) * 8;
    bf16x8 lq[2], lk[2], lv;
    const bf16x8 z8 = {0, 0, 0, 0, 0, 0, 0, 0};
#define HGP_ISSUE(CI) do { lq[0] = z8; lq[1] = z8; lk[0] = z8; lk[1] = z8; lv = z8; if ((CI) < 520) { \
      _Pragma("unroll") for (int r = 0; r < 2; ++r) { int pos, len; const int row = step_row((CI) * 32 + st0 + 16 * r, b, dir, pos, len); \
        const bf16_t* rp = p1 + (size_t)row * 7168; lq[r] = *(const bf16x8*)(rp + h * 128 + c8); lk[r] = *(const bf16x8*)(rp + 1024 + dir * 1024 + h * 128 + c8); } \
      if (pt < 64) { int pos, len; const int row = step_row((CI) * 32 + (pt >> 1), b, dir, pos, len); \
        lv = *(const bf16x8*)(p1 + (size_t)row * 7168 + 3072 + h * 128 + vb + (pt & 1) * 8); } } } while (0)
    HGP_ISSUE(0);
#pragma unroll 1
    for (int ci = -1; ci < 520; ++ci) {
      const int cn = ci + 1;
      float* B = bufs + (cn & 1) * 8704;
      if (cn < 520) {
#pragma unroll
        for (int r = 0; r < 2; ++r) {
          float qf[8], kf[8];
          unpack8(lq[r], qf); unpack8(lk[r], kf);
          float* dq = B + (st0 + 16 * r) * 128 + c8;
          *(float4*)dq = make_float4(qf[0], qf[1], qf[2], qf[3]); *(float4*)(dq + 4) = make_float4(qf[4], qf[5], qf[6], qf[7]);
          *(float4*)(dq + 4096) = make_float4(kf[0], kf[1], kf[2], kf[3]); *(float4*)(dq + 4100) = make_float4(kf[4], kf[5], kf[6], kf[7]);
        }
        if (pt < 64) {
          float vf[8]; unpack8(lv, vf);
          float* dv = B + 8192 + (pt >> 1) * 16 + (pt & 1) * 8;
          *(float4*)dv = make_float4(vf[0], vf[1], vf[2], vf[3]); *(float4*)(dv + 4) = make_float4(vf[4], vf[5], vf[6], vf[7]);
        }
      }
      HGP_ISSUE(cn + 1);
      __syncthreads();
    }
#undef HGP_ISSUE
  }
  __syncthreads();
}

__device__ __forceinline__ void hgrn2_block_task32(const Params& P, int t, char* smem) {
  const int tid = tid_(), wave = __builtin_amdgcn_readfirstlane(tid >> 6), lane = tid & 63;
  const int chain = t >> 2, vb = (t & 3) * 32, dir = chain & 1, h = (chain >> 1) & 7, b = chain >> 4;
  const bf16_t* p1 = P.RP;
  float* bufs = (float*)smem;
  __syncthreads();
  if (wave < 4) {
    __builtin_amdgcn_s_setprio(2);
    const int vi = lane >> 4, eg = lane & 15;
    bf16_t* oout = P.RA + (size_t)dir * MALL * 1024 + h * 128 + vb + wave * 8 + vi;
    const int rstep = dir ? -1 : 1;
    f32x2 S0[4], S1[4];
#pragma unroll
    for (int i = 0; i < 4; ++i) { S0[i] = (f32x2){0.f, 0.f}; S1[i] = (f32x2){0.f, 0.f}; }
    __syncthreads();
#pragma unroll 1
    for (int ci = 0; ci < 520; ++ci) {
      const float* B = bufs + (ci & 1) * 9216;
#pragma unroll 1
      for (int g = 0; g < 4; ++g) {
        int pos, len; const int r0 = step_row(ci * 32 + g * 8, b, dir, pos, len);
        float pa[8], pb[8];
#pragma unroll
        for (int u = 0; u < 8; ++u) {
          const int s = g * 8 + u;
          const float4 qa = *(const float4*)(B + s * 128 + eg * 8), qb = *(const float4*)(B + s * 128 + eg * 8 + 4);
          const float4 ka = *(const float4*)(B + 4096 + s * 128 + eg * 8), kb = *(const float4*)(B + 4096 + s * 128 + eg * 8 + 4);
          const float vf0 = B[8192 + s * 32 + wave * 8 + vi], vf1 = B[8192 + s * 32 + wave * 8 + 4 + vi];
          const f32x2 v0 = (f32x2){vf0, vf0}, v1 = (f32x2){vf1, vf1};
          const f32x2 k0 = (f32x2){ka.x, ka.y}, k1 = (f32x2){ka.z, ka.w}, k2 = (f32x2){kb.x, kb.y}, k3 = (f32x2){kb.z, kb.w};
          const f32x2 q0 = (f32x2){qa.x, qa.y}, q1 = (f32x2){qa.z, qa.w}, q2 = (f32x2){qb.x, qb.y}, q3 = (f32x2){qb.z, qb.w};
          S0[0] = k0 * (v0 - S0[0]) + S0[0]; S0[1] = k1 * (v0 - S0[1]) + S0[1]; S0[2] = k2 * (v0 - S0[2]) + S0[2]; S0[3] = k3 * (v0 - S0[3]) + S0[3];
          S1[0] = k0 * (v1 - S1[0]) + S1[0]; S1[1] = k1 * (v1 - S1[1]) + S1[1]; S1[2] = k2 * (v1 - S1[2]) + S1[2]; S1[3] = k3 * (v1 - S1[3]) + S1[3];
          f32x2 po = q0 * S0[0]; po = q1 * S0[1] + po; po = q2 * S0[2] + po; po = q3 * S0[3] + po;
          f32x2 pp = q0 * S1[0]; pp = q1 * S1[1] + pp; pp = q2 * S1[2] + pp; pp = q3 * S1[3] + pp;
          pa[u] = po.x + po.y; pb[u] = pp.x + pp.y;
        }
#pragma unroll
        for (int u = 0; u < 8; ++u) { pa[u] += __int_as_float(__builtin_amdgcn_mov_dpp(__float_as_int(pa[u]), 0xB1, 0xf, 0xf, true)); pb[u] += __int_as_float(__builtin_amdgcn_mov_dpp(__float_as_int(pb[u]), 0xB1, 0xf, 0xf, true)); }
#pragma unroll
        for (int u = 0; u < 8; ++u) { pa[u] += __int_as_float(__builtin_amdgcn_mov_dpp(__float_as_int(pa[u]), 0x4E, 0xf, 0xf, true)); pb[u] += __int_as_float(__builtin_amdgcn_mov_dpp(__float_as_int(pb[u]), 0x4E, 0xf, 0xf, true)); }
#pragma unroll
        for (int u = 0; u < 8; ++u) { pa[u] += __int_as_float(__builtin_amdgcn_mov_dpp(__float_as_int(pa[u]), 0x141, 0xf, 0xf, true)); pb[u] += __int_as_float(__builtin_amdgcn_mov_dpp(__float_as_int(pb[u]), 0x141, 0xf, 0xf, true)); }
#pragma unroll
        for (int u = 0; u < 8; ++u) { pa[u] += __int_as_float(__builtin_amdgcn_mov_dpp(__float_as_int(pa[u]), 0x140, 0xf, 0xf, true)); pb[u] += __int_as_float(__builtin_amdgcn_mov_dpp(__float_as_int(pb[u]), 0x140, 0xf, 0xf, true)); }
        if (eg == 0) {
#pragma unroll
          for (int u = 0; u < 8; ++u) { bf16_t* op = oout + (size_t)(r0 + rstep * u) * 1024; op[0] = f2bf(pa[u]); op[4] = f2bf(pb[u]); }
        }
      }
      __syncthreads();
    }
    __builtin_amdgcn_s_setprio(0);
  } else {
    const int pt = tid - 256;
    const int st0 = pt >> 4, c8 = (pt & 15) * 8;
    bf16x8 lq[2], lk[2], lv;
    const bf16x8 z8 = {0, 0, 0, 0, 0, 0, 0, 0};
#define HGP_ISSUE(CI) do { lq[0] = z8; lq[1] = z8; lk[0] = z8; lk[1] = z8; lv = z8; if ((CI) < 520) { \
      _Pragma("unroll") for (int r = 0; r < 2; ++r) { int pos, len; const int row = step_row((CI) * 32 + st0 + 16 * r, b, dir, pos, len); \
        const bf16_t* rp = p1 + (size_t)row * 7168; lq[r] = *(const bf16x8*)(rp + h * 128 + c8); lk[r] = *(const bf16x8*)(rp + 1024 + dir * 1024 + h * 128 + c8); } \
      if (pt < 128) { int pos, len; const int row = step_row((CI) * 32 + (pt >> 2), b, dir, pos, len); \
        lv = *(const bf16x8*)(p1 + (size_t)row * 7168 + 3072 + h * 128 + vb + (pt & 3) * 8); } } } while (0)
    HGP_ISSUE(0);
#pragma unroll 1
    for (int ci = -1; ci < 520; ++ci) {
      const int cn = ci + 1;
      float* B = bufs + (cn & 1) * 9216;
      if (cn < 520) {
#pragma unroll
        for (int r = 0; r < 2; ++r) {
          float qf[8], kf[8];
          unpack8(lq[r], qf); unpack8(lk[r], kf);
          float* dq = B + (st0 + 16 * r) * 128 + c8;
          *(float4*)dq = make_float4(qf[0], qf[1], qf[2], qf[3]); *(float4*)(dq + 4) = make_float4(qf[4], qf[5], qf[6], qf[7]);
          *(float4*)(dq + 4096) = make_float4(kf[0], kf[1], kf[2], kf[3]); *(float4*)(dq + 4100) = make_float4(kf[4], kf[5], kf[6], kf[7]);
        }
        if (pt < 128) {
          float vf[8]; unpack8(lv, vf);
          float* dv = B + 8192 + (pt >> 2) * 32 + (pt & 3) * 8;
          *(float4*)dv = make_float4(vf[0], vf[1], vf[2], vf[3]); *(float4*)(dv + 4) = make_float4(vf[4], vf[5], vf[6], vf[7]);
        }
      }
      HGP_ISSUE(cn + 1);
      __syncthreads();
    }
#undef HGP_ISSUE
  }
  __syncthreads();
}

template <int PASS>
__device__ __forceinline__ void rglru_task(const Params& P, int task, char* smem) {
  const int tid = tid_(), wave = __builtin_amdgcn_readfirstlane(tid >> 6), lane = tid & 63;
  const int grp = task % 52, chainidx = task / 52, hd = chainidx & 15, dir = (chainidx >> 4) & 1, b = chainidx >> 5;
  const bf16_t* p1 = P.RP;
  bf16_t* hout = P.RA + (size_t)(2 + dir) * MALL * 1024 + hd * 64;
  float* sumA = P.rgsum + (size_t)chainidx * 52 * 128;
  bf16_t* Bt = (bf16_t*)smem;
  bf16_t* At = Bt + 128 * 72;
  float* xbf = (float*)(At + 64 * 72);
  float* G = xbf + 4096;
  float* cst = G + 4 * 4096;
  float* car = G + 2 * 4096;
  __syncthreads();
  for (int i = tid; i < 64 * 128; i += NT) {
    int k = i >> 7, n = i & 127;
    float w = n < 64 ? P.rg_wa[((size_t)(dir * 16 + hd) * 64 + k) * 64 + n] : P.rg_wx[((size_t)(dir * 16 + hd) * 64 + k) * 64 + (n - 64)];
    Bt[n * 72 + k] = f2bf(w);
  }
  if (tid < 64) {
    cst[tid] = P.rg_ba[(dir * 16 + hd) * 64 + tid];
    cst[64 + tid] = P.rg_bx[(dir * 16 + hd) * 64 + tid];
    float lam = P.rg_lam[dir * 1024 + hd * 64 + tid];
    cst[128 + tid] = 8.f * log1pf(expf(-lam));
    for (int k = 0; k < 4; ++k) cst[192 + k * 64 + tid] = P.rg_conv_w[k * 1024 + hd * 64 + tid];
    cst[448 + tid] = P.rg_conv_b[hd * 64 + tid];
  }
  if (PASS == 2) for (int i = tid; i < grp * 128; i += NT) car[i] = sumA[i];
  float hstate = 0.f, aprod = 1.f;
  bf16x8 xr[2][4];
  const bf16x8 z8 = {0, 0, 0, 0, 0, 0, 0, 0};
#define RG_GEOM(CI, RBASE, PBASE, LEN) int RBASE, PBASE, LEN; { int pos0_; const int rf_ = step_row((CI) * 64, b, dir, pos0_, LEN); RBASE = dir ? rf_ - 63 : rf_; PBASE = dir ? pos0_ - 63 : pos0_; }
#define RG_ISSUE(CI, T0, STRIDE) do { RG_GEOM(CI, rb_, pb_, ln_); _Pragma("unroll") for (int r = 0; r < 2; ++r) { const int id = (T0) + (STRIDE) * r; \
      _Pragma("unroll") for (int k = 0; k < 4; ++k) xr[r][k] = z8; \
      if ((T0) >= 0 && id < 512) { const int tk = id >> 3, c8 = (id & 7) * 8; const bf16_t* rp = p1 + (size_t)(rb_ + tk) * 7168 + 5120 + hd * 64 + c8; \
        _Pragma("unroll") for (int k = 0; k < 4; ++k) { const int pp = pb_ + tk + k - 2; if (pp >= 0 && pp < ln_) xr[r][k] = *(const bf16x8*)(rp + (ptrdiff_t)(k - 2) * 7168); } } } } while (0)
#define RG_CONV(T0, STRIDE) do { _Pragma("unroll") for (int r = 0; r < 2; ++r) { const int id = (T0) + (STRIDE) * r; \
      if ((T0) >= 0 && id < 512) { const int tk = id >> 3, c8 = (id & 7) * 8; float acc[8]; \
        _Pragma("unroll") for (int j = 0; j < 8; ++j) acc[j] = cst[448 + c8 + j]; \
        _Pragma("unroll") for (int k = 0; k < 4; ++k) { _Pragma("unroll") for (int j = 0; j < 8; ++j) acc[j] += bf2f((bf16_t)xr[r][k][j]) * cst[192 + k * 64 + c8 + j]; } \
        bf16x8 o; _Pragma("unroll") for (int j = 0; j < 8; ++j) { o[j] = (short)f2bf(acc[j]); xbf[tk * 64 + c8 + j] = acc[j]; } \
        *(bf16x8*)(At + tk * 72 + c8) = o; } } } while (0)
  __syncthreads();
  if (PASS == 2 && wave == 0) {
    for (int g = 0; g < grp; ++g) hstate = car[g * 128 + lane] * hstate + car[g * 128 + 64 + lane];
  }
  RG_ISSUE(grp * 5, tid, 512);
  RG_CONV(tid, 512);
  __syncthreads();
  const int t1 = tid - 64;
#pragma unroll 1
  for (int cc = 0; cc < 5; ++cc) {
    const int ci = grp * 5 + cc;
    float* Ga = G + (cc & 1) * 8192; float* Gu = Ga + 4096;
    if (cc + 1 < 5) RG_ISSUE(ci + 1, t1, 448);
    {
      const int mt = wave >> 1, jh = wave & 1, fr = lane & 15, fq = lane >> 4;
#pragma unroll
      for (int jj = 0; jj < 2; ++jj) {
        const int jt = jh * 2 + jj;
        f32x4 accr = {0.f, 0.f, 0.f, 0.f}, acci = {0.f, 0.f, 0.f, 0.f};
#pragma unroll
        for (int ks = 0; ks < 2; ++ks) {
          bf16x8 a = *(const bf16x8*)(At + (mt * 16 + fr) * 72 + ks * 32 + fq * 8);
          bf16x8 br = *(const bf16x8*)(Bt + (jt * 16 + fr) * 72 + ks * 32 + fq * 8);
          bf16x8 bi = *(const bf16x8*)(Bt + (64 + jt * 16 + fr) * 72 + ks * 32 + fq * 8);
          accr = __builtin_amdgcn_mfma_f32_16x16x32_bf16(br, a, accr, 0, 0, 0);
          acci = __builtin_amdgcn_mfma_f32_16x16x32_bf16(bi, a, acci, 0, 0, 0);
        }
        const int tk = mt * 16 + fr, j0 = jt * 16 + fq * 4;
        const float4 xb4 = *(const float4*)(xbf + tk * 64 + j0);
        const float xbv[4] = {xb4.x, xb4.y, xb4.z, xb4.w};
        float av[4], uv[4];
#pragma unroll
        for (int e = 0; e < 4; ++e) {
          const float ra = fsig(accr[e] + cst[j0 + e]), ix = fsig(acci[e] + cst[64 + j0 + e]);
          const float log_a = -ra * cst[128 + j0 + e];
          av[e] = __expf(log_a);
          uv[e] = sqrtf(-expm1f(2.f * log_a)) * ix * xbv[e];
        }
        *(float4*)(Ga + tk * 64 + j0) = make_float4(av[0], av[1], av[2], av[3]);
        *(float4*)(Gu + tk * 64 + j0) = make_float4(uv[0], uv[1], uv[2], uv[3]);
      }
    }
    __syncthreads();
    if (wave == 0) {
#pragma unroll 8
      for (int s = 0; s < 64; ++s) {
        const int tk = dir ? 63 - s : s;
        const float a = Ga[tk * 64 + lane];
        hstate = a * hstate + Gu[tk * 64 + lane];
        if (PASS == 1) aprod *= a; else Gu[tk * 64 + lane] = hstate;
      }
    } else {
      if (PASS == 2 && cc > 0) {
        RG_GEOM(ci - 1, rbp, pbp, lnp);
        const float* Gp = G + ((cc - 1) & 1) * 8192 + 4096;
        for (int id = t1; id < 4096; id += 448) hout[(size_t)(rbp + (id >> 6)) * 1024 + (id & 63)] = f2bf(Gp[id]);
      }
      if (cc + 1 < 5) RG_CONV(t1, 448);
    }
    __syncthreads();
  }
  if (PASS == 2) {
    RG_GEOM(grp * 5 + 4, rbp, pbp, lnp);
    const float* Gp = G + (4 & 1) * 8192 + 4096;
    for (int id = tid; id < 4096; id += NT) hout[(size_t)(rbp + (id >> 6)) * 1024 + (id & 63)] = f2bf(Gp[id]);
  }
  if (PASS == 1 && wave == 0) { sumA[grp * 128 + lane] = aprod; sumA[grp * 128 + 64 + lane] = hstate; }
  __syncthreads();
#undef RG_GEOM
#undef RG_ISSUE
#undef RG_CONV
}

__device__ __forceinline__ void l1_readout_phase(const Params& P) {
  const int tid = tid_(), wave = tid >> 6, lane = tid & 63;
  const bf16_t* __restrict__ p1 = P.RP;
  const bf16_t* __restrict__ of = P.RA; const bf16_t* __restrict__ ob = P.RA + (size_t)MALL * 1024;
  const bf16_t* __restrict__ hf = P.RA + (size_t)2 * MALL * 1024; const bf16_t* __restrict__ hb = P.RA + (size_t)3 * MALL * 1024;
  bf16_t* __restrict__ Hout = P.H;
  for (int row = blockIdx.x * 8 + wave; row < MLAT; row += gridDim.x * 8)
#pragma unroll
  for (int part = 0; part < 8; ++part) {
    if (part < 4) {
      const int col = part * 256 + lane * 4;
      uint2 a = *(const uint2*)(of + (size_t)row * 1024 + col), bq = *(const uint2*)(ob + (size_t)row * 1024 + col);
      float o[4] = {bf2f(a.x & 0xffff) + bf2f(bq.x & 0xffff), bf2f(a.x >> 16) + bf2f(bq.x >> 16),
                    bf2f(a.y & 0xffff) + bf2f(bq.y & 0xffff), bf2f(a.y >> 16) + bf2f(bq.y >> 16)};
      float ss = o[0] * o[0] + o[1] * o[1] + o[2] * o[2] + o[3] * o[3];
#pragma unroll
      for (int m = 16; m >= 1; m >>= 1) ss += __shfl_xor(ss, m);
      const float rs = rsqrtf(ss * (1.f / 128.f) + 1e-6f);
      uint2 gu = *(const uint2*)(p1 + (size_t)row * 7168 + 4096 + col);
      float gv[4] = {bf2f(gu.x & 0xffff), bf2f(gu.x >> 16), bf2f(gu.y & 0xffff), bf2f(gu.y >> 16)};
      float r[4];
#pragma unroll
      for (int j = 0; j < 4; ++j) r[j] = o[j] * rs * P.hg_norm_w[col + j] * gv[j];
      uint2 u; u.x = pack2(r[0], r[1]); u.y = pack2(r[2], r[3]);
      *(uint2*)(Hout + (size_t)row * 2048 + col) = u;
    } else {
      const int col = (part - 4) * 256 + lane * 4;
      uint2 a = *(const uint2*)(hf + (size_t)row * 1024 + col), bq = *(const uint2*)(hb + (size_t)row * 1024 + col);
      uint2 gu = *(const uint2*)(p1 + (size_t)row * 7168 + 6144 + col);
      float r0 = (bf2f(a.x & 0xffff) + bf2f(bq.x & 0xffff)) * bf2f(gu.x & 0xffff);
      float r1 = (bf2f(a.x >> 16) + bf2f(bq.x >> 16)) * bf2f(gu.x >> 16);
      float r2 = (bf2f(a.y & 0xffff) + bf2f(bq.y & 0xffff)) * bf2f(gu.y & 0xffff);
      float r3 = (bf2f(a.y >> 16) + bf2f(bq.y >> 16)) * bf2f(gu.y >> 16);
      uint2 u; u.x = pack2(r0, r1); u.y = pack2(r2, r3);
      *(uint2*)(Hout + (size_t)row * 2048 + 1024 + col) = u;
    }
  }
}

#define XB_TMO      128
#define XB_XCNT(j)  (256  + 64 * (j))
#define XB_XSUB(j)  (1280 + 64 * (j))
#define XB_XGEN(j)  (2304 + 64 * (j))
#define XB_TOP      3328
#define XB_TOPGEN   3392
#define XCD_BAR_WORDS 3456
#define XB_SPIN_CAP (1u << 18)
#ifndef LAS
#define LAS __attribute__((address_space(3)))
#endif

__device__ __forceinline__ unsigned xb_ld(unsigned* p)              { return __hip_atomic_load(p, __ATOMIC_RELAXED, __HIP_MEMORY_SCOPE_AGENT); }
__device__ __forceinline__ unsigned xb_add(unsigned* p, unsigned v) { return __hip_atomic_fetch_add(p, v, __ATOMIC_RELAXED, __HIP_MEMORY_SCOPE_AGENT); }
__device__ __forceinline__ unsigned xb_xcc_id() { return (unsigned)__builtin_amdgcn_s_getreg((3 << 11) | 20) & 0xFu; }
#define XB_SPIN(cond, bar) do { unsigned _sp = 0; while (cond) { __builtin_amdgcn_s_sleep(1); \
    if ((++_sp & 255u) == 0u) { if (xb_ld(&(bar)[XB_TMO])) break; if (_sp > XB_SPIN_CAP) { atomicAdd(&(bar)[XB_TMO], 1u); break; } } } } while (0)

struct XcdBarrier {
    unsigned* bar; unsigned x;
    volatile LAS unsigned* st;
};

__device__ __forceinline__ XcdBarrier xcd_barrier_post(unsigned* bar, volatile LAS unsigned* st) {
    XcdBarrier b; b.bar = bar; b.x = xb_xcc_id(); b.st = st;
    if (threadIdx.x == 0) (void)xb_add(&bar[XB_XCNT(b.x)], 1u);
    return b;
}
__device__ __forceinline__ void xcd_barrier_complete(unsigned* bar, unsigned x, unsigned& nloc, unsigned& nx) {
    const unsigned G = gridDim.x * gridDim.y * gridDim.z;
    unsigned sum, cnt, mine, sp = 0u;
    for (;;) {
        sum = 0u; cnt = 0u; mine = 0u;
#pragma unroll
        for (unsigned j = 0; j < 16; ++j) { const unsigned c = xb_ld(&bar[XB_XCNT(j)]); sum += c; cnt += (c > 0u) ? 1u : 0u; mine = (j == x) ? c : mine; }
        if (sum == G) break;
        __builtin_amdgcn_s_sleep(1);
        if ((++sp & 255u) == 0u) { if (xb_ld(&bar[XB_TMO])) break; if (sp > XB_SPIN_CAP) { atomicAdd(&bar[XB_TMO], 1u); break; } }
    }
    nloc = mine > 0u ? mine : 1u; nx = cnt > 0u ? cnt : 1u;
}

__device__ __forceinline__ void xcd_barrier(const XcdBarrier& b) {
    asm volatile("s_waitcnt vmcnt(0)" ::: "memory");
    __syncthreads();
    if (threadIdx.x == 0) {
        unsigned* bar = b.bar;
        __builtin_amdgcn_s_waitcnt(0);
        unsigned nloc = b.st[0], nx = b.st[1];
        if (nloc == 0u) { xcd_barrier_complete(bar, b.x, nloc, nx); b.st[0] = nloc; b.st[1] = nx; }
        const unsigned old = xb_add(&bar[XB_XSUB(b.x)], 1u);
        const unsigned gen = old / nloc;
        if (old + 1u == (gen + 1u) * nloc) {
            __builtin_amdgcn_fence(__ATOMIC_RELEASE, "agent");
            asm volatile("s_waitcnt vmcnt(0)" ::: "memory");
            const unsigned og = xb_add(&bar[XB_TOP], 1u);
            const unsigned tg = og / nx;
            if (og + 1u == (tg + 1u) * nx) xb_add(&bar[XB_TOPGEN], 1u);
            else XB_SPIN(xb_ld(&bar[XB_TOPGEN]) == tg, bar);
            __builtin_amdgcn_fence(__ATOMIC_ACQUIRE, "agent");
            xb_add(&bar[XB_XGEN(b.x)], 1u);
            asm volatile("s_waitcnt vmcnt(0)" ::: "memory");
        } else {
            XB_SPIN(xb_ld(&bar[XB_XGEN(b.x)]) == gen, bar);
            __builtin_amdgcn_fence(__ATOMIC_ACQUIRE, "agent");
            asm volatile("s_waitcnt vmcnt(0)" ::: "memory");
        }
    }
    __syncthreads();
}


__global__ void __launch_bounds__(NT) mega(Params P) {
  extern __shared__ __attribute__((aligned(16))) char smem[];
  cg::grid_group grid = cg::this_grid();
  const int G = gridDim.x, bid = blockIdx.x, tid = tid_();
  const float* mod0 = P.mod; const float* mod1 = P.mod + 3 * 12288;

  if (bid == 0 && tid == 0) { P.hyq[0] = 0; P.hyq[64] = 0; }
  if (bid == 0) for (int i = tid; i < XCD_BAR_WORDS; i += NT) P.xbar[i] = 0u;
  volatile LAS unsigned* xst = (volatile LAS unsigned*)(smem + 143360 - 16);
  if (tid == 0) { xst[0] = 0u; xst[1] = 0u; xst[2] = 0u; xst[3] = 0u; }
  __syncthreads();
  for (int t = bid; t < 192; t += G) adaln_task(P, smem, t);
  {
    int gb = 192;
    gb = cvt_run(P.ev_w_in, 2048, 6784, P.w_in_t, smem, gb);
    gb = cvt_run(P.ev_w_out, 2048, 2048, P.w_out_t, smem, gb);
    gb = cvt_run(P.mlp_w1, 2048, 8192, P.w1_t, smem, gb);
    gb = cvt_run(P.mlp_w2, 8192, 2048, P.w2_t, smem, gb);
    gb = cvt_run(P.hy_f_w3, 64, 4096, P.w3t, smem, gb);
    gb = cvt_run(P.rw_g2, 256, 1024, P.g2t, smem, gb);
  }
  hyena_h2_phase(P, smem);
  for (int i = bid * NT + tid; i < 32768; i += G * NT) {
    if (i < 16384) { float s, c; sincospif(-(float)i / 8192.f, &s, &c); P.tw[i] = make_float2(c, s); }
    else { int n = i - 16384; float s, c; sincospif(-(float)n / 16384.f, &s, &c); P.half[n] = make_float2(c, s); }
  }
  grid.sync();
  const XcdBarrier xb = xcd_barrier_post(P.xbar, xst);
  norm_phase(P.x, P.ctx, P.norm_w, mod0, 0, P.H, MALL, 0);
  xcd_barrier(xb);
  {
    int gb = 0;
    ALoadPlain aH{P.H, 2048};
    int rot = 0;
    rot = pg8_run(smem, P.w_in_t, P.H, 3072, MALL, 2048, PEpiBf16<ActNone>{P.RP, (size_t)MALL, MALL, ActNone{}}, rot);
    rot = pg8_run(smem, P.H, P.w_in_t + (size_t)3072 * 2048, MALL, 3840, 2048, PEpiBf16<ActNone>{P.RP + (size_t)3072 * MALL, 3712, 3712, ActNone{}}, rot);
    gb = rot;
    gb = gemm_run<true>(ALoadPlain{P.h2b, 64}, P.w3t, 64, LSEQ, 4096, EpTransF32{P.out, (size_t)LSEQ}, smem, gb);
    gb = gemm_run<true>(ALoadPlain{P.h2cb, 64}, P.w3t, 64, 256, 4096, EpTransF32{P.tapsc, 256}, smem, gb);
  }
  xcd_barrier(xb);
  for (int c = bid; c < 1024; c += G) hyena_ctx_channel(P, c, smem);
  gemm_run<false>(ALoadG{P.RP + (size_t)3072 * MALL, P.rw_mu}, P.g2t, 256, MALL, 1024, EpBf16{P.RA + (size_t)2 * MALL * 1024, 1024}, smem, 0);
  {
    const int nR = G >= 256 ? 128 : 0;
    if (nR) { if (bid < nR) rwkv_scan_task(P, bid, smem); }
    else { _Pragma("unroll 1") for (int t = bid; t < 128; t += G) rwkv_scan_task(P, t, smem); }
    __syncthreads();
    if (tid < 256) { float sn, cs; if (tid < 128) sincospif(-(float)tid / 64.f, &sn, &cs); else sincospif(-(float)(tid - 128) / 8192.f, &sn, &cs);
      ((float2*)(smem + 131072 + 1024))[tid] = make_float2(cs, sn); }
    _Pragma("unroll 1") for (;;) {
      int* cslot = (int*)(smem + 131072 + 512);
      __syncthreads();
      if (tid == 0) *cslot = atomicAdd(P.hyq, 1);
      __syncthreads();
      const int c = *cslot;
      if (c >= 1024) break;
      hyena_channel(P, c, smem);
    }
  }
  xcd_barrier(xb);
  rwkv_readout_phase(P);
  hyena_transpose_phase(P, smem);
  xcd_barrier(xb);
  pg8_run(smem, P.H, P.w_out_t, MLAT, 2048, 2048, PEpiResid{P.x, P.ctx, P.out, P.xc, mod0, 2, 0}, 0);
  pg8_ctx_splitk(smem, P.H + (size_t)MLAT * 2048, P.w_out_t, 2048, (float*)(P.RA + (size_t)50 * 1048576), 0);
  xcd_barrier(xb);
  norm_phase(P.out, P.ctx, P.norm_w + 2048, mod0, 3, P.H, MALL, 0, (float*)(P.RA + (size_t)50 * 1048576), mod0 + 2 * 12288 + 2 * 2048, P.xc);
  {
    int gb = 0;
    gb = cvt_run(P.od_w_in, 2048, 7168, P.w_in_t, smem, gb);
  }
  xcd_barrier(xb);
  pg8_run(smem, P.H, P.w1_t, MALL, 8192, 2048, PEpiBf16<ActSqRelu>{P.RP, 8192, 8192, ActSqRelu{}}, 0);
  xcd_barrier(xb);
  pg8_run(smem, P.RP, P.w2_t, MLAT, 2048, 8192, PEpiResid{P.out, P.xc, P.out, P.xc, mod0, 5, 0}, 0);
  pg8_ctx_splitk(smem, P.RP + (size_t)MLAT * 8192, P.w2_t, 8192, (float*)(P.RA + (size_t)50 * 1048576), 0);
  xcd_barrier(xb);
  norm_phase(P.out, P.xc, P.norm_w + 4096, mod1, 0, P.H, MALL, 1, (float*)(P.RA + (size_t)50 * 1048576), mod0 + 2 * 12288 + 5 * 2048, P.xc);
  xcd_barrier(xb);
  pg8_run(smem, P.H, P.w_in_t, MALL, 7168, 2048, PEpiBf16<ActIn1>{P.RP, 7168, 7168, ActIn1{P.hg_lb}}, 0);
  xcd_barrier(xb);
  if (G >= 256) {
    if (bid < 128) hgrn2_block_task32(P, bid, smem);
    else {
      const int nB = G - 128;
      _Pragma("unroll 1") for (int t = bid - 128; t < 3328; t += nB) rglru_task<1>(P, t, smem);
      __syncthreads();
      if (tid == 0) {
        __threadfence();
        atomicAdd(P.hyq + 64, 1);
        int spins = 0;
        while (atomicAdd(P.hyq + 64, 0) < nB && ++spins < 400000) __builtin_amdgcn_s_sleep(8);
        __threadfence();
      }
      __syncthreads();
      _Pragma("unroll 1") for (int t = bid - 128; t < 3328; t += nB) rglru_task<2>(P, t, smem);
      {
        int gb = 0;
        gb = cvt_run_r(P.od_w_out, 2048, 2048, P.w_out_t, smem, gb, bid - 128, nB);
        gb = cvt_run_r(P.mlp_w1 + (size_t)2048 * 8192, 2048, 8192, P.w1_t, smem, gb, bid - 128, nB);
        gb = cvt_run_r(P.mlp_w2 + (size_t)2048 * 8192, 8192, 2048, P.w2_t, smem, gb, bid - 128, nB);
      }
    }
    xcd_barrier(xb);
  } else {
    _Pragma("unroll 1") for (int t = bid; t < 3328; t += G) rglru_task<1>(P, t, smem);
    _Pragma("unroll 1") for (int t = bid; t < 128; t += G) hgrn2_block_task32(P, t, smem);
    xcd_barrier(xb);
    _Pragma("unroll 1") for (int t = bid; t < 3328; t += G) rglru_task<2>(P, t, smem);
    {
      int gb = 0;
      gb = cvt_run(P.od_w_out, 2048, 2048, P.w_out_t, smem, gb);
      gb = cvt_run(P.mlp_w1 + (size_t)2048 * 8192, 2048, 8192, P.w1_t, smem, gb);
      gb = cvt_run(P.mlp_w2 + (size_t)2048 * 8192, 8192, 2048, P.w2_t, smem, gb);
    }
    xcd_barrier(xb);
  }
  l1_readout_phase(P);
  xcd_barrier(xb);
  pg8_run(smem, P.H, P.w_out_t, MLAT, 2048, 2048, PEpiResid{P.out, P.xc, P.out, P.xc, mod1, 2, 1}, 0);
  xcd_barrier(xb);
  norm_phase(P.out, P.xc, P.norm_w + 6144, mod1, 3, P.H, MLAT, 0);
  xcd_barrier(xb);
  pg8_run(smem, P.H, P.w1_t, MLAT, 8192, 2048, PEpiBf16<ActSqRelu>{P.RP, 8192, 8192, ActSqRelu{}}, 0);
  xcd_barrier(xb);
  pg8_run(smem, P.RP, P.w2_t, MLAT, 2048, 8192, PEpiResid{P.out, P.xc, P.out, P.xc, mod1, 5, 0}, 0);
  xcd_barrier(xb);
  final_norm_phase(P.out, P.final_norm_w);
}

extern "C" void kernel_launch(void* const* d_in, const int* in_sizes, int n_in, void* d_out, int out_size,
                              void* d_ws, size_t ws_size, hipStream_t stream) {
  constexpr size_t kDynLds = 143360;
  static int grid_blocks = 0;
  if (!grid_blocks) {
    hipFuncSetAttribute((const void*)mega, hipFuncAttributeMaxDynamicSharedMemorySize, (int)kDynLds);
    int dev = 0, cus = 0, per_cu = 0;
    hipGetDevice(&dev);
    hipDeviceGetAttribute(&cus, hipDeviceAttributeMultiprocessorCount, dev);
    hipOccupancyMaxActiveBlocksPerMultiprocessor(&per_cu, mega, NT, kDynLds);
    if (per_cu < 1) per_cu = 1;
    grid_blocks = cus;
  }
  Params p{};
  const float* const* in = (const float* const*)d_in;
  p.x = in[0]; p.c = in[1]; p.ctx = in[2]; p.c_ctx = in[3]; p.ada_w = in[4]; p.ada_b = in[5]; p.norm_w = in[6];
  p.mlp_w1 = in[7]; p.mlp_w2 = in[8]; p.final_norm_w = in[9]; p.ev_w_in = in[10]; p.ev_w_out = in[11];
  p.hy_conv_w = in[12]; p.hy_conv_b = in[13]; p.hy_f_w1 = in[14]; p.hy_f_b1 = in[15]; p.hy_f_w2 = in[16]; p.hy_f_b2 = in[17];
  p.hy_f_w3 = in[18]; p.hy_freq = in[19]; p.hy_bias = in[20]; p.rw_mu = in[21]; p.rw_w0 = in[22]; p.rw_w2 = in[23];
  p.rw_a0 = in[24]; p.rw_a2 = in[25]; p.rw_g2 = in[26]; p.rw_k_k = in[27]; p.rw_k_a = in[28]; p.rw_r_k = in[29];
  p.rw_ln_w = in[30]; p.rw_ln_b = in[31]; p.od_w_in = in[32]; p.od_w_out = in[33]; p.hg_lb = in[34]; p.hg_norm_w = in[35];
  p.rg_conv_w = in[36]; p.rg_conv_b = in[37]; p.rg_wa = in[38]; p.rg_ba = in[39]; p.rg_wx = in[40]; p.rg_bx = in[41]; p.rg_lam = in[42];
  p.out = (float*)d_out;
  char* ws = (char*)d_ws;
  p.mod = (float*)(ws);
  p.tw = (float2*)(ws + 512 * 1024);
  p.half = (float2*)(ws + 640 * 1024);
  p.h2b = (bf16_t*)(ws + 1 * MiB);
  p.h2cb = (bf16_t*)(ws + 3 * MiB);
  p.tapsc = (float*)(ws + 4 * MiB);
  p.xc = (float*)(ws + 8 * MiB);
  p.bonus = (float*)(ws + 12 * MiB);
  p.w3t = (bf16_t*)(ws + 17 * MiB);
  p.g2t = (bf16_t*)(ws + 17 * MiB + 512 * 1024);
  p.rgsum = (float*)(ws + 18 * MiB);
  p.hyq = (int*)(ws + 384 * 1024);
  p.xbar = (unsigned*)(ws + 448 * 1024);
  p.w_in_t = (bf16_t*)(ws + 24 * MiB);
  p.w_out_t = (bf16_t*)(ws + 52 * MiB);
  p.w1_t = (bf16_t*)(ws + 60 * MiB);
  p.w2_t = (bf16_t*)(ws + 92 * MiB);
  p.H = (bf16_t*)(ws + 124 * MiB);
  p.RP = (bf16_t*)(ws + 254 * MiB);
  p.RA = (bf16_t*)(ws + 709 * MiB);
  void* args[] = {&p};
  hipError_t e = hipLaunchCooperativeKernel((void*)mega, dim3(grid_blocks), dim3(NT), args, kDynLds, stream);
  if (e != hipSuccess) fprintf(stderr, "coop launch failed: %s\n", hipGetErrorString(e));
}
```
